# Optimizing an MI355X kernel written in HIP

```python
import math
import jax
import jax.numpy as jnp
from jax import lax
import numpy as np

D_MODEL = 1024
BATCH = 4
SEQ = 4096
DEPTH = 4

GRID_W = 64
CTX_LEN = 256
N_EVEN = (DEPTH + 1) // 2
N_ODD = DEPTH // 2

FOURIER_GROUPS = 4
FOURIER_DIM = 128
FOURIER_WIDTH = FOURIER_GROUPS * FOURIER_DIM
NA_HEADS = 8
NA_HEAD_DIM = 64
NA_WIDTH = NA_HEADS * NA_HEAD_DIM
NA_KH_MAX = 8
NA_KW = 16
AB_IN = FOURIER_WIDTH + 3 * NA_WIDTH
AB_OUT = FOURIER_WIDTH + NA_WIDTH
DIFF_HEADS = 8
DIFF_HEAD_DIM = 64
DIFF_V_DIM = 2 * DIFF_HEAD_DIM
DIFF_QK_WIDTH = DIFF_HEADS * 2 * DIFF_HEAD_DIM
DIFF_V_WIDTH = DIFF_HEADS * DIFF_V_DIM
ROPE_THETA = 10000.0
Q_BLOCK = 128
MLP_HIDDEN = 4 * D_MODEL
NORM_EPS = 1e-6
SUBLN_EPS = 1e-5
NEG_INF = -1e30

kernel_name = 'hybrid_fourier_natten_diffattn_dit'


def rms_norm(x, g, eps=NORM_EPS):
    xf = x.astype(jnp.float32)
    y = xf * lax.rsqrt(jnp.mean(xf * xf, axis=-1, keepdims=True) + eps)
    return (y * g.astype(jnp.float32)).astype(x.dtype)


def modulate(x, g, shift, scale):
    return rms_norm(x, g) * (1.0 + scale) + shift


def squared_relu_mlp(h, w_in, w_out):
    return jnp.square(jax.nn.relu(h @ w_in)) @ w_out


def to_heads(t, n_heads):
    b, l, _ = t.shape
    return t.reshape(b, l, n_heads, -1).transpose(0, 2, 1, 3)


def dense_attention(q, k, v):
    s = jnp.einsum('bhqd,bhkd->bhqk', q, k).astype(jnp.float32) * (q.shape[-1] ** -0.5)
    p = jax.nn.softmax(s, axis=-1).astype(v.dtype)
    return jnp.einsum('bhqk,bhkd->bhqd', p, v)


def fourier_mix(f):
    b, l, _ = f.shape
    z = f.reshape(b, l, FOURIER_GROUPS, FOURIER_DIM).astype(jnp.float32)
    y = jnp.fft.fft2(z, axes=(1, 3), norm='ortho').real
    return y.reshape(b, l, FOURIER_WIDTH).astype(f.dtype)


def neighbourhood_attention(q, k, v, kc, vc, rpb):
    b, n, _ = q.shape
    h, d, w = NA_HEADS, NA_HEAD_DIM, GRID_W
    rows_n = n // w
    kh = min(NA_KH_MAX, rows_n)

    def grid(t):
        return t.reshape(b, rows_n, w, h, d).transpose(0, 3, 1, 2, 4)

    qg = grid(q) * (d ** -0.5)
    kg, vg = grid(k), grid(v)
    kch, vch = to_heads(kc, h), to_heads(vc, h)

    r = jnp.arange(rows_n)
    col = jnp.arange(w)
    row_start = jnp.clip(r - kh // 2, 0, rows_n - kh)
    key_rows = row_start[:, None] + jnp.arange(kh)
    k_win = kg[:, :, key_rows]
    v_win = vg[:, :, key_rows]

    col_start = jnp.clip(col - NA_KW // 2, 0, w - NA_KW)
    in_win = (col[None, :] >= col_start[:, None]) & (col[None, :] < col_start[:, None] + NA_KW)
    dr = key_rows - r[:, None] + (NA_KH_MAX - 1)
    dc = jnp.clip(col[None, :] - col[:, None], -(NA_KW - 1), NA_KW - 1) + (NA_KW - 1)
    bias = rpb[:, dr[:, None, :, None], dc[None, :, None, :]].astype(jnp.float32)

    s_win = jnp.einsum('bhrqd,bhrjkd->bhrqjk', qg, k_win).astype(jnp.float32) + bias
    s_win = jnp.where(in_win[:, None, :], s_win, NEG_INF)
    s_ctx = jnp.einsum('bhrqd,bhkd->bhrqk', qg, kch).astype(jnp.float32)
    s = jnp.concatenate([s_win.reshape(b, h, rows_n, w, kh * w), s_ctx], axis=-1)
    p = jax.nn.softmax(s, axis=-1).astype(v.dtype)
    p_win = p[..., :kh * w].reshape(b, h, rows_n, w, kh, w)
    p_ctx = p[..., kh * w:]
    o = (jnp.einsum('bhrqjk,bhrjkd->bhrqd', p_win, v_win)
         + jnp.einsum('bhrqk,bhkd->bhrqd', p_ctx, vch))
    return o.transpose(0, 2, 3, 1, 4).reshape(b, n, NA_WIDTH)


def fourier_na_mixer(hl, hc, w_in, w_out, rpb, with_ctx_out):
    splits = [FOURIER_WIDTH, FOURIER_WIDTH + NA_WIDTH, FOURIER_WIDTH + 2 * NA_WIDTH]
    fl, ql, kl, vl = jnp.split(hl @ w_in, splits, axis=-1)
    fc, qc, kc, vc = jnp.split(hc @ w_in, splits, axis=-1)
    yl = jnp.concatenate([fourier_mix(fl), neighbourhood_attention(ql, kl, vl, kc, vc, rpb)], axis=-1) @ w_out
    if not with_ctx_out:
        return yl, None
    oc = dense_attention(to_heads(qc, NA_HEADS), to_heads(kc, NA_HEADS), to_heads(vc, NA_HEADS))
    oc = oc.transpose(0, 2, 1, 3).reshape(hc.shape[0], hc.shape[1], NA_WIDTH)
    yc = jnp.concatenate([fourier_mix(fc), oc], axis=-1) @ w_out
    return yl, yc


def axial_rope(t, rows, cols):
    half = t.shape[-1] // 2
    nf = half // 2
    inv_freq = ROPE_THETA ** (-jnp.arange(nf, dtype=jnp.float32) / nf)

    def rotate(u, pos):
        ang = pos.astype(jnp.float32)[:, None] * inv_freq
        cos = jnp.cos(ang)[:, None, None, :]
        sin = jnp.sin(ang)[:, None, None, :]
        u = u.astype(jnp.float32)
        u1, u2 = u[..., :nf], u[..., nf:]
        return jnp.concatenate([u1 * cos - u2 * sin, u1 * sin + u2 * cos], axis=-1)

    out = jnp.concatenate([rotate(t[..., :half], rows), rotate(t[..., half:], cols)], axis=-1)
    return out.astype(t.dtype)


def diff_attn_core(q, k, v, lam):
    s = jnp.einsum('bhiqd,bhikd->bhiqk', q, k).astype(jnp.float32) * (q.shape[-1] ** -0.5)
    p = jax.nn.softmax(s, axis=-1)
    a = (p[:, :, 0] - lam * p[:, :, 1]).astype(v.dtype)
    return jnp.einsum('bhqk,bhkd->bhqd', a, v)


def diff_attention_mixer(hl, hc, w_qkv, w_out, lq1, lk1, lq2, lk2, subln_g, lam_init, rows, cols, with_ctx_out):
    h, d, dv = DIFF_HEADS, DIFF_HEAD_DIM, DIFF_V_DIM

    def project(x_):
        b_, l_, _ = x_.shape
        q, k, v = jnp.split(x_ @ w_qkv, [DIFF_QK_WIDTH, 2 * DIFF_QK_WIDTH], axis=-1)
        return q.reshape(b_, l_, h, 2, d), k.reshape(b_, l_, h, 2, d), v.reshape(b_, l_, h, dv)

    ql, kl, vl = project(hl)
    qc, kc, vc = project(hc)
    ql, kl = axial_rope(ql, rows, cols), axial_rope(kl, rows, cols)
    lam = (jnp.exp(jnp.sum((lq1 * lk1).astype(jnp.float32)))
           - jnp.exp(jnp.sum((lq2 * lk2).astype(jnp.float32))) + lam_init)

    kc_h = kc.transpose(0, 2, 3, 1, 4)
    vc_h = vc.transpose(0, 2, 1, 3)
    k_all = jnp.concatenate([kc_h, kl.transpose(0, 2, 3, 1, 4)], axis=3)
    v_all = jnp.concatenate([vc_h, vl.transpose(0, 2, 1, 3)], axis=2)

    b, n = hl.shape[0], hl.shape[1]
    nb = n // Q_BLOCK
    q_blocks = ql.reshape(b, nb, Q_BLOCK, h, 2, d).transpose(1, 0, 3, 4, 2, 5)
    ol = lax.map(lambda qb: diff_attn_core(qb, k_all, v_all, lam), q_blocks)
    ol = ol.transpose(1, 0, 3, 2, 4).reshape(b, n, h, dv)

    def head_out(o):
        o = rms_norm(o, subln_g, SUBLN_EPS) * (1.0 - lam_init)
        return o.reshape(o.shape[0], o.shape[1], DIFF_V_WIDTH) @ w_out

    yl = head_out(ol)
    if not with_ctx_out:
        return yl, None
    oc = diff_attn_core(qc.transpose(0, 2, 3, 1, 4), kc_h, vc_h, lam).transpose(0, 2, 1, 3)
    return yl, head_out(oc)


def setup_inputs(seed: int = 0) -> dict:
    key = jax.random.key(seed)
    ks = jax.random.split(key, 22)
    D = D_MODEL

    def nrm(k, shape, scale):
        return jax.random.normal(k, shape, jnp.float32) * scale

    return {
        'x': nrm(ks[0], (BATCH, SEQ, D), 1.0),
        'c': nrm(ks[1], (BATCH, D), 1.0),
        'ctx': nrm(ks[2], (BATCH, CTX_LEN, D), 1.0),
        'c_ctx': nrm(ks[3], (D,), 1.0),
        'w_mod': nrm(ks[4], (DEPTH, D, 6 * D), 0.5 * D ** -0.5),
        'b_mod': nrm(ks[5], (DEPTH, 6 * D), 0.02),
        'norm_mix_g': 1.0 + nrm(ks[6], (DEPTH, D), 0.02),
        'norm_mlp_g': 1.0 + nrm(ks[7], (DEPTH, D), 0.02),
        'w_mlp_in': nrm(ks[8], (DEPTH, D, MLP_HIDDEN), D ** -0.5),
        'w_mlp_out': nrm(ks[9], (DEPTH, MLP_HIDDEN, D), MLP_HIDDEN ** -0.5),
        'w_in_ab': nrm(ks[10], (N_EVEN, D, AB_IN), D ** -0.5),
        'w_out_ab': nrm(ks[11], (N_EVEN, AB_OUT, D), AB_OUT ** -0.5),
        'na_rpb': nrm(ks[12], (N_EVEN, NA_HEADS, 2 * NA_KH_MAX - 1, 2 * NA_KW - 1), 0.1),
        'w_qkv_diff': nrm(ks[13], (N_ODD, D, 2 * DIFF_QK_WIDTH + DIFF_V_WIDTH), D ** -0.5),
        'w_out_diff': nrm(ks[14], (N_ODD, DIFF_V_WIDTH, D), DIFF_V_WIDTH ** -0.5),
        'diff_lq1': nrm(ks[15], (N_ODD, DIFF_HEAD_DIM), 0.1),
        'diff_lk1': nrm(ks[16], (N_ODD, DIFF_HEAD_DIM), 0.1),
        'diff_lq2': nrm(ks[17], (N_ODD, DIFF_HEAD_DIM), 0.1),
        'diff_lk2': nrm(ks[18], (N_ODD, DIFF_HEAD_DIM), 0.1),
        'diff_subln_g': 1.0 + nrm(ks[19], (N_ODD, DIFF_V_DIM), 0.02),
        'final_norm_g': 1.0 + nrm(ks[20], (D,), 0.02),
    }


def reference(x, c, ctx, c_ctx, w_mod, b_mod, norm_mix_g, norm_mlp_g, w_mlp_in, w_mlp_out,
              w_in_ab, w_out_ab, na_rpb, w_qkv_diff, w_out_diff, diff_lq1, diff_lk1, diff_lq2, diff_lk2,
              diff_subln_g, final_norm_g):
    n = x.shape[1]
    t = jnp.arange(n)
    rows, cols = t // GRID_W, t % GRID_W
    c_act = jax.nn.silu(c)
    cc_act = jax.nn.silu(c_ctx)
    xl, xc = x, ctx
    for i in range(DEPTH):
        last = i == DEPTH - 1
        ml = jnp.split((c_act @ w_mod[i] + b_mod[i])[:, None, :], 6, axis=-1)
        mc = jnp.split(cc_act @ w_mod[i] + b_mod[i], 6, axis=-1)
        hl = modulate(xl, norm_mix_g[i], ml[0], ml[1])
        hc = modulate(xc, norm_mix_g[i], mc[0], mc[1])
        j = i // 2
        if i % 2 == 0:
            yl, yc = fourier_na_mixer(hl, hc, w_in_ab[j], w_out_ab[j], na_rpb[j], not last)
        else:
            lam_init = 0.8 - 0.6 * math.exp(-0.3 * i)
            yl, yc = diff_attention_mixer(hl, hc, w_qkv_diff[j], w_out_diff[j], diff_lq1[j], diff_lk1[j],
                                          diff_lq2[j], diff_lk2[j], diff_subln_g[j], lam_init,
                                          rows, cols, not last)
        xl = xl + ml[2] * yl
        xl = xl + ml[5] * squared_relu_mlp(modulate(xl, norm_mlp_g[i], ml[3], ml[4]), w_mlp_in[i], w_mlp_out[i])
        if not last:
            xc = xc + mc[2] * yc
            xc = xc + mc[5] * squared_relu_mlp(modulate(xc, norm_mlp_g[i], mc[3], mc[4]), w_mlp_in[i], w_mlp_out[i])
    return rms_norm(xl, final_norm_g)
```

```cpp
#include <hip/hip_runtime.h>
#include <hip/hip_cooperative_groups.h>
#include <cstdio>
namespace cg = cooperative_groups;

#define DI __device__ __forceinline__
#define LAS __attribute__((address_space(3)))
#define GAS __attribute__((address_space(1)))
typedef unsigned short bf16_t;
typedef short bf16x8 __attribute__((ext_vector_type(8)));
typedef float f32x2 __attribute__((ext_vector_type(2)));
typedef float f32x4 __attribute__((ext_vector_type(4)));
typedef float f32x16 __attribute__((ext_vector_type(16)));
typedef unsigned u32x2 __attribute__((ext_vector_type(2)));
typedef unsigned u32x4 __attribute__((ext_vector_type(4)));
typedef __bf16 bf2_t __attribute__((ext_vector_type(2)));

constexpr int NROWS = 17408, TPB = 4352;
constexpr float LOG2E = 1.4426950408889634f;
constexpr float QSCALE = 0.125f * LOG2E;

constexpr size_t al256(size_t x) { return (x + 255) & ~(size_t)255; }
constexpr size_t OFF_CTL = 0;
constexpr size_t OFF_ROWSQ = 256;
constexpr size_t OFF_BAR = al256(256 + 9 * (size_t)NROWS * 4);
constexpr size_t CTL_BYTES = al256(OFF_BAR + 3456 * 4);
constexpr size_t OFF_MOD = CTL_BYTES;
constexpr size_t OFF_SWMIX = OFF_MOD + 4 * 5 * 6144 * 4;
constexpr size_t OFF_SWMLP = OFF_SWMIX + 4 * 5 * 3072 * 4;
constexpr size_t OFF_LAM = OFF_SWMLP + 4 * 5 * 4096 * 4;
constexpr size_t OFF_ROPE = OFF_LAM + 256;
constexpr size_t OFF_XC = OFF_ROPE + 8192;
constexpr size_t OFF_XB = OFF_XC + 1024 * 1024 * 4;
constexpr size_t OFF_WINAB = OFF_XB + (size_t)NROWS * 1024 * 2;
constexpr size_t OFF_WOUTAB = OFF_WINAB + 2 * 2560 * 1024 * 2;
constexpr size_t OFF_WQKV = OFF_WOUTAB + 2 * 1024 * 1024 * 2;
constexpr size_t OFF_WOUTD = OFF_WQKV + 2 * 3072 * 1024 * 2;
constexpr size_t OFF_WMI = OFF_WOUTD + 2 * 1024 * 1024 * 2;
constexpr size_t OFF_WMO = OFF_WMI + 4ull * 4096 * 1024 * 2;
constexpr size_t OFF_TP = OFF_WMO + 4ull * 4096 * 1024 * 2;
constexpr size_t OFF_D128 = OFF_TP + 65536ull * 256 * 2;
constexpr size_t OFF_DFTC = OFF_D128 + 256 * 256 * 2;
constexpr size_t OFF_U = OFF_DFTC + 256 * 512 * 2;
constexpr size_t OFF_QK = OFF_U;
constexpr size_t OFF_FTL = OFF_QK + (size_t)NROWS * 1024 * 2;
constexpr size_t OFF_FTC = OFF_FTL + 2048ull * 8192 * 2;
constexpr size_t OFF_VT = OFF_QK + (size_t)NROWS * 2048 * 2;
constexpr size_t OFF_CAT = OFF_VT + (size_t)NROWS * 1024 * 2;
constexpr size_t OFF_R16 = OFF_U + (size_t)NROWS * 4096 * 2;
constexpr size_t OFF_RSQ16 = OFF_R16 + (size_t)NROWS * 1024 * 2;
constexpr size_t WS_END = OFF_RSQ16 + 9ull * NROWS * 16 * 4;
static_assert(OFF_CAT + (size_t)NROWS * 1024 * 2 == OFF_R16, "overlay");
static_assert(OFF_FTC + 2048ull * 512 * 2 == OFF_VT, "overlay2");
constexpr int LDS_BYTES = 131072 + 256;

struct P {
    const float* in[21];
    float* out;
    unsigned char* ws;
};

template <class T> DI T* as_global(T* p) { return (T*)(GAS T*)p; }
DI unsigned pk2(float a, float b) { bf2_t r = __builtin_convertvector((f32x2){a, b}, bf2_t); return __builtin_bit_cast(unsigned, r); }
DI bf16_t bf1(float a) { return (bf16_t)(pk2(a, 0.f) & 0xffffu); }
DI float wave_sum(float v) {
#pragma unroll
    for (int o = 1; o < 64; o <<= 1) v += __shfl_xor(v, o);
    return v;
}
DI int get_tid(int wave_s) { int lane; asm volatile("v_mbcnt_lo_u32_b32 %0, -1, 0\n\tv_mbcnt_hi_u32_b32 %0, -1, %0" : "=v"(lane)); return wave_s * 64 + lane; }
#define MFMA32(a, b, c) __builtin_amdgcn_mfma_f32_32x32x16_bf16((a), (b), (c), 0, 0, 0)

#define XB_TMO      128
#define XB_XCNT(j)  (256  + 64 * (j))
#define XB_XSUB(j)  (1280 + 64 * (j))
#define XB_XGEN(j)  (2304 + 64 * (j))
#define XB_TOP      3328
#define XB_TOPGEN   3392
#define XB_SPIN_CAP (1u << 20)
DI unsigned xb_ld(unsigned* p)              { return __hip_atomic_load(p, __ATOMIC_RELAXED, __HIP_MEMORY_SCOPE_AGENT); }
DI unsigned xb_add(unsigned* p, unsigned v) { return __hip_atomic_fetch_add(p, v, __ATOMIC_RELAXED, __HIP_MEMORY_SCOPE_AGENT); }
DI unsigned xb_xcc_id() { return (unsigned)__builtin_amdgcn_s_getreg((3 << 11) | 20) & 0xFu; }
#define XB_SPIN(cond, bar) do { unsigned _sp = 0; while (cond) { __builtin_amdgcn_s_sleep(1); \
    if ((++_sp & 255u) == 0u) { if (xb_ld(&(bar)[XB_TMO])) break; if (_sp > XB_SPIN_CAP) { atomicAdd(&(bar)[XB_TMO], 1u); break; } } } } while (0)
struct XcdBarrier { unsigned* bar; unsigned x; volatile LAS unsigned* st; };
DI XcdBarrier xcd_barrier_post(unsigned* bar, volatile LAS unsigned* st) {
    XcdBarrier b; b.bar = bar; b.x = xb_xcc_id(); b.st = st;
    if (threadIdx.x == 0) (void)xb_add(&bar[XB_XCNT(b.x)], 1u);
    return b;
}
DI void xcd_barrier_complete(unsigned* bar, unsigned x, unsigned& nloc, unsigned& nx) {
    const unsigned G = gridDim.x * gridDim.y * gridDim.z;
    unsigned sum, cnt, mine, sp = 0u;
    for (;;) {
        sum = 0u; cnt = 0u; mine = 0u;
#pragma unroll
        for (unsigned j = 0; j < 16; ++j) { const unsigned c = xb_ld(&bar[XB_XCNT(j)]); sum += c; cnt += (c > 0u) ? 1u : 0u; mine = (j == x) ? c : mine; }
        if (sum == G) break;
        __builtin_amdgcn_s_sleep(1);
        if ((++sp & 255u) == 0u) { if (xb_ld(&bar[XB_TMO])) break; if (sp > XB_SPIN_CAP) { atomicAdd(&bar[XB_TMO], 1u); break; } }
    }
    nloc = mine > 0u ? mine : 1u; nx = cnt > 0u ? cnt : 1u;
}
DI void xcd_barrier(const XcdBarrier& b, const int tid) {
    asm volatile("s_waitcnt vmcnt(0)" ::: "memory");
    __syncthreads();
    if (tid == 0) {
        unsigned* bar = b.bar;
        __builtin_amdgcn_s_waitcnt(0);
        unsigned nloc = b.st[0], nx = b.st[1];
        if (nloc == 0u) { xcd_barrier_complete(bar, b.x, nloc, nx); b.st[0] = nloc; b.st[1] = nx; }
        const unsigned old = xb_add(&bar[XB_XSUB(b.x)], 1u);
        const unsigned gen = old / nloc;
        if (old + 1u == (gen + 1u) * nloc) {
            __builtin_amdgcn_fence(__ATOMIC_RELEASE, "agent");
            asm volatile("s_waitcnt vmcnt(0)" ::: "memory");
            const unsigned og = xb_add(&bar[XB_TOP], 1u);
            const unsigned tg = og / nx;
            if (og + 1u == (tg + 1u) * nx) xb_add(&bar[XB_TOPGEN], 1u);
            else XB_SPIN(xb_ld(&bar[XB_TOPGEN]) == tg, bar);
            __builtin_amdgcn_fence(__ATOMIC_ACQUIRE, "agent");
            xb_add(&bar[XB_XGEN(b.x)], 1u);
            asm volatile("s_waitcnt vmcnt(0)" ::: "memory");
        } else {
            XB_SPIN(xb_ld(&bar[XB_XGEN(b.x)]) == gen, bar);
            __builtin_amdgcn_fence(__ATOMIC_ACQUIRE, "agent");
            asm volatile("s_waitcnt vmcnt(0)" ::: "memory");
        }
    }
    __syncthreads();
}

namespace pg8 {
constexpr int BM = 256, BK = 64, HALF = 128, HTB = HALF * BK * 2, STAGE_BYTES = 8 * HTB, NXCD = 8, WGM = 8;
DI int lds_byte(int r, int c) { const int st = (r >> 4) * 2 + (c >> 5), rr = r & 15, cc = c & 31, ob = rr * 64 + cc * 2; return st * 1024 + (ob ^ (((ob >> 9) & 1) << 5)); }
DI void stage_rc(int b, int& R, int& C) { const int st = b / 1024, sb = b % 1024, swz = sb ^ (((sb >> 9) & 1) << 5); R = (st >> 1) * 16 + swz / 64; C = (st & 1) * 32 + (swz % 64) / 2; }
DI int perm32(int rho) { const int n = rho >> 4, i = rho & 15; return 8 * (i >> 2) + 4 * n + (i & 3); }
struct Unit { int pm, pn; };
struct Gemm { const bf16_t* A; const bf16_t* Bt; int M, N, K; };
struct StaticOrder {
    int nM, nN, nwg, G, c, skip;
    DI void init(int M, int N, int G_, int c_, int skip_) { nM = M / BM; nN = N / BM; nwg = nM * nN; G = G_; c = c_; skip = skip_; }
    DI bool next(int i, Unit& u) const {
        const long L = (long)i * G + c; if (L >= nwg) return false;
        int wgid = (int)L; { const int q = nwg / NXCD, r = nwg % NXCD, xcd = wgid % NXCD, off = wgid / NXCD; wgid = (xcd < r ? xcd * (q + 1) : r * (q + 1) + (xcd - r) * q) + off; }
        const int nig = WGM * nN, gid = wgid / nig, fm = gid * WGM, gsz = (nM - fm) < WGM ? (nM - fm) : WGM;
        u.pm = fm + ((wgid % nig) % gsz); u.pn = (wgid % nig) / gsz; if (skip) u.pm += (u.pm >> 4) + 1; return true;
    }
};

template <class Epi>
DI void gemm_phase(LAS unsigned char* lds, const Gemm g, const StaticOrder& S, const Epi& E, const int tid) {
    const int wid = __builtin_amdgcn_readfirstlane(tid >> 6), lane = tid & 63, wr = wid >> 2, wc = wid & 3, fr = lane & 15, fq = lane >> 4;
    const int K = g.K, nt = K / BK;
    unsigned voffA[2], voffB[2];
#pragma unroll
    for (int i = 0; i < 2; ++i) { int R, C; stage_rc(tid * 16 + i * 8192, R, C); const int Rb = E.perm ? ((R & ~31) + perm32(R & 31)) : R;
        voffA[i] = (unsigned)(R * K + C) * 2u; voffB[i] = (unsigned)(Rb * K + C) * 2u; }
    const size_t kstep = (size_t)(BK * 2);
    const size_t hstep = (size_t)HALF * K * 2;
    const size_t tstep = 2 * hstep;
    const unsigned ldsw = (unsigned)wid * 1024u;
    const int aoff = lds_byte(wr * 64 + fr, fq * 8), boff = lds_byte(wc * 32 + fr, fq * 8);
#define PG8_SA(b, h) (((b) * 2 + (h)) * HTB)
#define PG8_SB(b, h) ((4 + (b) * 2 + (h)) * HTB)
#define PG8_STAGE(bufoff, gbase, voff) do { _Pragma("unroll") for (int _i = 0; _i < 2; ++_i) \
        __builtin_amdgcn_global_load_lds((const unsigned*)((const char*)(gbase) + (voff)[_i]), (LAS unsigned*)(lds + (bufoff) + ldsw + _i * 8192), 16, 0, 0); } while (0)
#define PG8_LDA(dst, b, h) do { _Pragma("unroll") for (int m = 0; m < 4; ++m) _Pragma("unroll") for (int k = 0; k < 2; ++k) dst[m][k] = *(const LAS bf16x8*)(lds + PG8_SA(b, h) + aoff + m * 2048 + k * 1024); } while (0)
#define PG8_LDB(dst, b, h) do { _Pragma("unroll") for (int n = 0; n < 2; ++n) _Pragma("unroll") for (int k = 0; k < 2; ++k) dst[n][k] = *(const LAS bf16x8*)(lds + PG8_SB(b, h) + boff + n * 2048 + k * 1024); } while (0)
#define PG8_MMA(ai, bj, At, Bt) do { __builtin_amdgcn_s_setprio(1); _Pragma("unroll") for (int m = 0; m < 4; ++m) _Pragma("unroll") for (int n = 0; n < 2; ++n) _Pragma("unroll") for (int k = 0; k < 2; ++k) \
        acc[ai][bj][m][n] = __builtin_amdgcn_mfma_f32_16x16x32_bf16(Bt[n][k], At[m][k], acc[ai][bj][m][n], 0, 0, 0); __builtin_amdgcn_s_setprio(0); } while (0)
#define PG8_WAIT_V(n) asm volatile("s_waitcnt vmcnt(" #n ")" ::: "memory")
#define PG8_WAIT_L(n) asm volatile("s_waitcnt lgkmcnt(" #n ")" ::: "memory")
#define PG8_BAR __builtin_amdgcn_s_barrier()
#define PG8_SCHED __builtin_amdgcn_sched_barrier(0)
    Unit cur, nxt; int ui = 0;
    if (!S.next(0, cur)) return;
    f32x4 acc[2][2][4][2];
#pragma unroll
    for (int a = 0; a < 2; ++a)
#pragma unroll
        for (int b = 0; b < 2; ++b)
#pragma unroll
            for (int m = 0; m < 4; ++m)
#pragma unroll
                for (int n = 0; n < 2; ++n) acc[a][b][m][n] = (f32x4){0.f, 0.f, 0.f, 0.f};
    bf16x8 At[4][2], B0[2][2], B1[2][2];
    const char* cA = (const char*)g.A + (size_t)cur.pm * tstep; const char* cB = (const char*)g.Bt + (size_t)cur.pn * tstep;
    PG8_STAGE(PG8_SB(0, 0), cB, voffB); PG8_STAGE(PG8_SA(0, 0), cA, voffA); PG8_STAGE(PG8_SB(0, 1), cB + hstep, voffB); PG8_STAGE(PG8_SA(0, 1), cA + hstep, voffA);
    if (wr == 1) PG8_BAR;
    PG8_WAIT_V(4); PG8_BAR;
    PG8_STAGE(PG8_SB(1, 0), cB + kstep, voffB); PG8_STAGE(PG8_SA(1, 0), cA + kstep, voffA); PG8_STAGE(PG8_SB(1, 1), cB + hstep + kstep, voffB);
    PG8_WAIT_V(6); PG8_BAR;
    for (;;) {
        const bool has_next = S.next(ui + 1, nxt);
        const char* nA = has_next ? (const char*)g.A + (size_t)nxt.pm * tstep : cA; const char* nB = has_next ? (const char*)g.Bt + (size_t)nxt.pn * tstep : cB;
        for (int t = 0; t < nt; t += 2) {
            const bool last = (t == nt - 2);
            const char* a1 = cA + (size_t)(t + 1) * kstep;
            const char* a2 = last ? nA : cA + (size_t)(t + 2) * kstep; const char* b2 = last ? nB : cB + (size_t)(t + 2) * kstep;
            const char* a3 = a2 + kstep; const char* b3 = b2 + kstep;
            PG8_LDB(B0, 0, 0); PG8_SCHED; PG8_LDA(At, 0, 0); PG8_STAGE(PG8_SA(1, 1), a1 + hstep, voffA);
            PG8_WAIT_L(8); PG8_BAR; PG8_WAIT_L(0); PG8_MMA(0, 0, At, B0); PG8_BAR; PG8_SCHED;
            PG8_LDB(B1, 0, 1); PG8_STAGE(PG8_SB(0, 0), b2, voffB);
            PG8_BAR; PG8_WAIT_L(0); PG8_MMA(0, 1, At, B1); PG8_BAR;
            PG8_LDA(At, 0, 1); PG8_STAGE(PG8_SA(0, 0), a2, voffA);
            PG8_BAR; PG8_WAIT_L(0); PG8_MMA(1, 0, At, B0); PG8_BAR; PG8_SCHED;
            PG8_STAGE(PG8_SB(0, 1), b2 + hstep, voffB);
            PG8_WAIT_V(6); PG8_BAR; PG8_MMA(1, 1, At, B1); PG8_BAR;
            PG8_LDB(B0, 1, 0); PG8_SCHED; PG8_LDA(At, 1, 0); PG8_STAGE(PG8_SA(0, 1), a2 + hstep, voffA);
            PG8_WAIT_L(8); PG8_BAR; PG8_WAIT_L(0); PG8_MMA(0, 0, At, B0); PG8_BAR; PG8_SCHED;
            PG8_LDB(B1, 1, 1); PG8_STAGE(PG8_SB(1, 0), b3, voffB);
            PG8_BAR; PG8_WAIT_L(0); PG8_MMA(0, 1, At, B1); PG8_BAR;
            PG8_LDA(At, 1, 1); PG8_STAGE(PG8_SA(1, 0), a3, voffA);
            PG8_BAR; PG8_WAIT_L(0); PG8_MMA(1, 0, At, B0); PG8_BAR; PG8_SCHED;
            PG8_STAGE(PG8_SB(1, 1), b3 + hstep, voffB);
            PG8_WAIT_V(6); PG8_BAR; PG8_MMA(1, 1, At, B1); PG8_BAR;
        }
        { int t2 = tid; asm volatile("" : "+v"(t2)); const int w2 = __builtin_amdgcn_readfirstlane(t2 >> 6), l2 = t2 & 63; E(acc, cur, w2 >> 2, w2 & 3, l2 & 15, l2 >> 4); }
        if (!has_next) break;
#pragma unroll
        for (int a = 0; a < 2; ++a)
#pragma unroll
            for (int b = 0; b < 2; ++b)
#pragma unroll
                for (int m = 0; m < 4; ++m)
#pragma unroll
                    for (int n = 0; n < 2; ++n) acc[a][b][m][n] = (f32x4){0.f, 0.f, 0.f, 0.f};
        cur = nxt; cA = nA; cB = nB; ++ui;
    }
    PG8_WAIT_V(0);
    if (wr == 0) PG8_BAR;
    PG8_BAR;
#undef PG8_SA
#undef PG8_SB
#undef PG8_STAGE
#undef PG8_LDA
#undef PG8_LDB
#undef PG8_MMA
#undef PG8_WAIT_V
#undef PG8_WAIT_L
#undef PG8_BAR
#undef PG8_SCHED
}
}

DI int perm_pos(int t) { return (t & ~12) | ((t & 4) << 1) | ((t & 8) >> 1); }
struct Epi {
    int mode;
    int perm, l, s;
    unsigned char* wsp; float* outp; const float* in0; const float* in2; const float* in6; const float* in7;
};
struct ColVec { f32x4 a0, a1, b0, b1; };
DI ColVec load_colvec(const Epi& E, unsigned char* ws, int l_, int bsel, int c0) {
    ColVec cv;
    if (E.mode <= 2) {
        const int nsw = (E.mode == 2) ? 4096 : 3072;
        const float* sw = (E.mode == 2) ? (const float*)(ws + OFF_SWMLP) + (size_t)l_ * 5 * 4096 : (const float*)(ws + OFF_SWMIX) + (size_t)l_ * 5 * 3072;
        const float* q = sw + (size_t)bsel * nsw + c0;
        cv.a0 = *(const f32x4*)q; cv.a1 = *(const f32x4*)(q + 4); cv.b0 = cv.a0; cv.b1 = cv.a1;
    } else {
        const float* MOD = (const float*)(ws + OFF_MOD);
        const bool first = (E.s == 2);
        const float* gate = MOD + (size_t)l_ * 5 * 6144 + (first ? 2 : 5) * 1024 + (size_t)bsel * 6144 + c0;
        cv.a0 = *(const f32x4*)gate; cv.a1 = *(const f32x4*)(gate + 4);
        const float* gnext = first ? E.in7 + l_ * 1024 : (l_ < 3 ? E.in6 + (l_ + 1) * 1024 : nullptr);
        if (gnext) { const float* sc = (first ? MOD + (size_t)l_ * 5 * 6144 + 4 * 1024 : MOD + (size_t)(l_ + 1) * 5 * 6144 + 1024) + (size_t)bsel * 6144 + c0;
            cv.b0 = *(const f32x4*)(gnext + c0) * (*(const f32x4*)sc + 1.0f); cv.b1 = *(const f32x4*)(gnext + c0 + 4) * (*(const f32x4*)(sc + 4) + 1.0f); }
        else { cv.b0 = (f32x4){0.f, 0.f, 0.f, 0.f}; cv.b1 = cv.b0; }
    }
    return cv;
}
DI float row_rstd(const Epi& E, unsigned char* ws, int l_, int row) {
    const f32x4* q = (const f32x4*)((const float*)(ws + OFF_RSQ16) + ((size_t)(2 * l_ + (E.mode == 2 ? 1 : 0)) * NROWS + row) * 16);
    const f32x4 a = q[0], b_ = q[1], c = q[2], d = q[3];
    const f32x4 t = (a + b_) + (c + d);
    return rsqrtf(((t[0] + t[1]) + (t[2] + t[3])) * (1.0f / 1024.0f) + 1e-6f);
}
DI float emit8(const Epi& E, unsigned char* ws, int l_, int row, int b, int tall, bool isctx, int c0, float (&v)[8], const ColVec& cv, float rstd) {
    if (E.mode <= 2) {
#pragma unroll
        for (int i = 0; i < 4; ++i) { v[i] = v[i] * rstd + cv.a0[i]; v[4 + i] = v[4 + i] * rstd + cv.a1[i]; }
        if (E.mode == 2) {
            bf16_t* ob = (bf16_t*)(ws + OFF_U);
#pragma unroll
            for (int i = 0; i < 8; ++i) { const float r = fmaxf(v[i], 0.f); v[i] = r * r; }
            u32x4 w; w.x = pk2(v[0], v[1]); w.y = pk2(v[2], v[3]); w.z = pk2(v[4], v[5]); w.w = pk2(v[6], v[7]);
            *(u32x4*)(ob + (size_t)row * 4096 + c0) = w;
        } else if (E.mode == 0) {
            if (c0 < 1024) {
                const int cs = c0 >> 9; const int gc0 = (c0 & 511);
                if (isctx) { bf16_t* d = (bf16_t*)(ws + OFF_FTC) + ((size_t)(b * 512 + gc0) * 2 + cs) * 256 + tall;
#pragma unroll
                    for (int i = 0; i < 8; ++i) d[(size_t)i * 512] = bf1(v[i]);
                } else { bf16_t* d = (bf16_t*)(ws + OFF_FTL) + ((size_t)(b * 512 + gc0) * 2 + cs) * 4096 + (tall - 256);
#pragma unroll
                    for (int i = 0; i < 8; ++i) d[(size_t)i * 8192] = bf1(v[i]); }
            } else if (c0 < 2048) {
                const float sc = (c0 < 1536) ? QSCALE : 1.0f;
                u32x4 w; w.x = pk2(v[0] * sc, v[1] * sc); w.y = pk2(v[2] * sc, v[3] * sc); w.z = pk2(v[4] * sc, v[5] * sc); w.w = pk2(v[6] * sc, v[7] * sc);
                *(u32x4*)((bf16_t*)(ws + OFF_QK) + (size_t)row * 1024 + (c0 - 1024)) = w;
            } else {
                const int cv_ = c0 - 2048; const int h = cv_ >> 6, d0 = cv_ & 63;
                bf16_t* d = (bf16_t*)(ws + OFF_VT) + ((size_t)((b * 8 + h) * 64 + d0)) * TPB + perm_pos(tall);
#pragma unroll
                for (int i = 0; i < 8; ++i) d[(size_t)i * TPB] = bf1(v[i]);
            }
        } else {
            if (c0 < 2048) {
                if (!isctx) {
                    const int t = tall - 256; const int pos = ((c0 >> 5) & 1) ? (t & 63) : (t >> 6);
                    const float* rp = (const float*)(ws + OFF_ROPE) + (size_t)(pos * 16 + (c0 & 8)) * 2;
                    const bool hi2 = ((c0 >> 4) & 1) != 0;
#pragma unroll
                    for (int i = 0; i < 8; ++i) { const float pv = __shfl_xor(v[i], 32); const float cs_ = rp[2 * i], sn = rp[2 * i + 1];
                        v[i] = hi2 ? (pv * sn + v[i] * cs_) : (v[i] * cs_ - pv * sn); }
                }
                const float sc = (c0 < 1024) ? QSCALE : 1.0f;
                u32x4 w; w.x = pk2(v[0] * sc, v[1] * sc); w.y = pk2(v[2] * sc, v[3] * sc); w.z = pk2(v[4] * sc, v[5] * sc); w.w = pk2(v[6] * sc, v[7] * sc);
                *(u32x4*)((bf16_t*)(ws + OFF_QK) + (size_t)row * 2048 + c0) = w;
            } else {
                const int cv_ = c0 - 2048; const int h = cv_ >> 7, d0 = cv_ & 127;
                bf16_t* d = (bf16_t*)(ws + OFF_VT) + ((size_t)((b * 8 + h) * 128 + d0)) * TPB + perm_pos(tall);
#pragma unroll
                for (int i = 0; i < 8; ++i) d[(size_t)i * TPB] = bf1(v[i]);
            }
        }
        return 0.f;
    } else {
        const bool l0 = (E.s == 2) && l_ == 0;
        const bool lastw = (E.s == 4) && l_ == 3;
        f32x4 r0, r1;
        if (l0) { const size_t rloc = isctx ? (size_t)(b * 256 + tall) : (size_t)(b * 4096 + tall - 256);
            const float* rp = (isctx ? E.in2 : E.in0) + rloc * 1024 + c0; r0 = __builtin_nontemporal_load((const f32x4*)rp); r1 = __builtin_nontemporal_load((const f32x4*)(rp + 4)); }
        else { const u32x4 rw = __builtin_nontemporal_load((const u32x4*)((const bf16_t*)(ws + OFF_R16) + (size_t)row * 1024 + c0));
            r0 = (f32x4){__uint_as_float(rw.x << 16), __uint_as_float(rw.x & 0xffff0000u), __uint_as_float(rw.y << 16), __uint_as_float(rw.y & 0xffff0000u)};
            r1 = (f32x4){__uint_as_float(rw.z << 16), __uint_as_float(rw.z & 0xffff0000u), __uint_as_float(rw.w << 16), __uint_as_float(rw.w & 0xffff0000u)}; }
        const f32x4 x0 = r0 + cv.a0 * (f32x4){v[0], v[1], v[2], v[3]};
        const f32x4 x1 = r1 + cv.a1 * (f32x4){v[4], v[5], v[6], v[7]};
        if (lastw) { float* op = E.outp + (size_t)(b * 4096 + tall - 256) * 1024 + c0; *(f32x4*)op = x0; *(f32x4*)(op + 4) = x1; }
        else { u32x4 w; w.x = pk2(x0[0], x0[1]); w.y = pk2(x0[2], x0[3]); w.z = pk2(x1[0], x1[1]); w.w = pk2(x1[2], x1[3]);
            *(u32x4*)((bf16_t*)(ws + OFF_R16) + (size_t)row * 1024 + c0) = w; }
        const bool has_next = (E.s == 2) || l_ < 3;
        if (has_next) { const f32x4 y0 = x0 * cv.b0, y1 = x1 * cv.b1; u32x4 w; w.x = pk2(y0[0], y0[1]); w.y = pk2(y0[2], y0[3]); w.z = pk2(y1[0], y1[1]); w.w = pk2(y1[2], y1[3]);
            *(u32x4*)((bf16_t*)(ws + OFF_XB) + (size_t)row * 1024 + c0) = w; }
        return ((x0[0] * x0[0] + x0[1] * x0[1]) + (x0[2] * x0[2] + x0[3] * x0[3])) + ((x1[0] * x1[0] + x1[1] * x1[1]) + (x1[2] * x1[2] + x1[3] * x1[3]));
    }
}
DI float* rowsq_out_ptr(const Epi& E, unsigned char* ws, int l_) { return (float*)(ws + OFF_RSQ16) + (size_t)(2 * l_ + (E.s == 2 ? 1 : 2)) * NROWS * 16; }

struct EpiPg8 {
    Epi E; int perm;
    DI void operator()(const f32x4 (&acc)[2][2][4][2], const pg8::Unit& u, int wr, int wc, int fr, int fq) const {
        unsigned z_ = 0u; int l_ = E.l; asm volatile("" : "+s"(z_), "+s"(l_)); unsigned char* ws = E.wsp + z_;
        if (E.mode <= 2) {
            const int b = u.pm / 17, tp = u.pm % 17; const bool isctx = (tp == 0); const int bsel = isctx ? 4 : b;
            const int colt = u.pn * 256 + wc * 32 + 8 * fq;
            ColVec cv[2];
#pragma unroll
            for (int bj = 0; bj < 2; ++bj) cv[bj] = load_colvec(E, ws, l_, bsel, colt + 128 * bj);
#pragma unroll
            for (int ai = 0; ai < 2; ++ai)
#pragma unroll
                for (int m = 0; m < 4; ++m) {
                    const int rl = ai * 128 + wr * 64 + m * 16 + fr; const int row = u.pm * 256 + rl; const int tall = tp * 256 + rl;
                    const float rstd = row_rstd(E, ws, l_, row);
#pragma unroll
                    for (int bj = 0; bj < 2; ++bj) {
                        float v[8];
#pragma unroll
                        for (int i = 0; i < 4; ++i) { v[i] = acc[ai][bj][m][0][i]; v[4 + i] = acc[ai][bj][m][1][i]; }
                        (void)emit8(E, ws, l_, row, b, tall, isctx, colt + 128 * bj, v, cv[bj], rstd);
                    }
                }
        } else if (E.mode == 3) {
            const int b = u.pm / 17, tp = u.pm % 17; const bool isctx = (tp == 0); const int bsel = isctx ? 4 : b;
            const int colt = u.pn * 256 + wc * 32 + 8 * fq;
            ColVec cv[2];
#pragma unroll
            for (int bj = 0; bj < 2; ++bj) cv[bj] = load_colvec(E, ws, l_, bsel, colt + 128 * bj);
            float* rso = rowsq_out_ptr(E, ws, l_);
#pragma unroll
            for (int ai = 0; ai < 2; ++ai)
#pragma unroll
                for (int m = 0; m < 4; ++m) {
                    const int rl = ai * 128 + wr * 64 + m * 16 + fr; const int row = u.pm * 256 + rl; const int tall = tp * 256 + rl;
                    float ss = 0.f;
#pragma unroll
                    for (int bj = 0; bj < 2; ++bj) {
                        float v[8];
#pragma unroll
                        for (int i = 0; i < 4; ++i) { v[i] = acc[ai][bj][m][0][i]; v[4 + i] = acc[ai][bj][m][1][i]; }
                        ss += emit8(E, ws, l_, row, b, tall, isctx, colt + 128 * bj, v, cv[bj], 0.f);
                    }
                    ss += __shfl_xor(ss, 16); ss += __shfl_xor(ss, 32);
                    if (fq == 0) rso[(size_t)row * 16 + u.pn * 4 + wc] = ss;
                }
        } else if (E.mode == 4) {
            bf16_t* ob = (bf16_t*)(ws + OFF_CAT);
            const float alpha = 0.0013810679320049757f;
#pragma unroll
            for (int ai = 0; ai < 2; ++ai)
#pragma unroll
                for (int m = 0; m < 4; ++m) {
                    const int R = u.pm * 256 + ai * 128 + wr * 64 + m * 16 + fr;
                    const int b = R >> 14, k1 = (R >> 9) & 31, gc = R & 511;
                    const int k2 = wc * 32 + 8 * fq;
                    bf16_t* d = ob + (size_t)(b * TPB + 256 + k1 + 32 * k2) * 1024 + gc;
#pragma unroll
                    for (int i = 0; i < 4; ++i) { d[(size_t)i * 32 * 1024] = bf1(acc[ai][0][m][0][i] * alpha); d[(size_t)(4 + i) * 32 * 1024] = bf1(acc[ai][0][m][1][i] * alpha); }
                }
        } else {
            bf16_t* ob = (bf16_t*)(ws + OFF_CAT);
            const float alpha = 0.005524271728019903f;
            const int nrow0 = u.pn * 256 + wc * 32 + 8 * fq;
#pragma unroll
            for (int ai = 0; ai < 2; ++ai)
#pragma unroll
                for (int m = 0; m < 4; ++m) {
                    const int k = u.pm * 256 + ai * 128 + wr * 64 + m * 16 + fr;
#pragma unroll
                    for (int bj = 0; bj < 2; ++bj) { const int nr = nrow0 + 128 * bj; const int b = nr >> 9, gc = nr & 511;
                        const f32x4 a0 = acc[ai][bj][m][0] * alpha, a1 = acc[ai][bj][m][1] * alpha;
                        u32x4 w; w.x = pk2(a0[0], a0[1]); w.y = pk2(a0[2], a0[3]); w.z = pk2(a1[0], a1[1]); w.w = pk2(a1[2], a1[3]);
                        *(u32x4*)(ob + (size_t)(b * TPB + k) * 1024 + gc) = w; }
                }
        }
    }
};

constexpr int bitrev5(int x) { return ((x & 1) << 4) | ((x & 2) << 2) | (x & 4) | ((x & 8) >> 2) | ((x & 16) >> 4); }
DI float bf2f(bf16_t v) { return __uint_as_float(((unsigned)v) << 16); }
DI void fft_stage1_item(unsigned char* ws, int item, int tid) {
    constexpr float FC[16] = {1.0f, 0.98078528040323043f, 0.92387953251128674f, 0.83146961230254524f, 0.70710678118654752f, 0.55557023301960218f, 0.38268343236508977f, 0.19509032201612825f,
                              0.0f, -0.19509032201612825f, -0.38268343236508977f, -0.55557023301960218f, -0.70710678118654752f, -0.83146961230254524f, -0.92387953251128674f, -0.98078528040323043f};
    constexpr float FS[16] = {0.0f, 0.19509032201612825f, 0.38268343236508977f, 0.55557023301960218f, 0.70710678118654752f, 0.83146961230254524f, 0.92387953251128674f, 0.98078528040323043f,
                              1.0f, 0.98078528040323043f, 0.92387953251128674f, 0.83146961230254524f, 0.70710678118654752f, 0.55557023301960218f, 0.38268343236508977f, 0.19509032201612825f};
    const int nrow = item * 4 + (tid >> 7), n2 = tid & 127;
    const bf16_t* src = (const bf16_t*)(ws + OFF_FTL) + (size_t)nrow * 8192 + n2;
    float ar[32], ai[32];
#pragma unroll
    for (int n1 = 0; n1 < 32; ++n1) { ar[bitrev5(n1)] = bf2f(src[128 * n1]); ai[bitrev5(n1)] = -bf2f(src[4096 + 128 * n1]); }
#pragma unroll
    for (int st = 1; st <= 5; ++st) {
        const int m = 1 << st, h = m >> 1;
#pragma unroll
        for (int k = 0; k < 32; k += m)
#pragma unroll
            for (int jj = 0; jj < h; ++jj) {
                const int idx = jj * (32 / m);
                const float wr_ = FC[idx], wi_ = -FS[idx];
                const float xr = ar[k + jj + h], xi = ai[k + jj + h];
                const float tr = wr_ * xr - wi_ * xi, ti = wr_ * xi + wi_ * xr;
                const float ur = ar[k + jj], ui = ai[k + jj];
                ar[k + jj] = ur + tr; ai[k + jj] = ui + ti; ar[k + jj + h] = ur - tr; ai[k + jj + h] = ui - ti;
            }
    }
    const int b = nrow >> 9, gc = nrow & 511;
    bf16_t* dst = (bf16_t*)(ws + OFF_TP) + ((size_t)(b * 32) * 512 + gc) * 256 + n2;
#pragma unroll
    for (int k1 = 0; k1 < 32; ++k1) {
        const float rev = (float)(n2 * k1) * (1.0f / 4096.0f);
        const float c = __builtin_amdgcn_cosf(rev), sn = __builtin_amdgcn_sinf(rev);
        const float re = ar[k1] * c + ai[k1] * sn, im = ai[k1] * c - ar[k1] * sn;
        dst[(size_t)k1 * 512 * 256] = bf1(re); dst[(size_t)k1 * 512 * 256 + 128] = bf1(im);
    }
}

DI int mini_perm(int p) { const int q = p & 255, xcd = q & 7, idx = q >> 3; return (p & ~255) + ((((idx >> 4) + 2 * xcd) & 15) << 4) + (idx & 15); }
DI void mini_gemm_tile(const Epi& E, const bf16_t* A, const bf16_t* Bt, int K, int mt_lin, unsigned char* shm, int tid) {
    const int mt = mini_perm(mt_lin);
    const int rt = mt & 15, ct = mt >> 4;
    const int wv = tid >> 6, lane = tid & 63, l31 = lane & 31, hi = lane >> 5;
    const int ksl = K >> 3, kbeg = wv * ksl;
    const bf16_t* ap[2]; const bf16_t* bp[2];
#pragma unroll
    for (int mi = 0; mi < 2; ++mi) { const int r = rt * 64 + 32 * mi + l31; const int grow = (r >> 8) * TPB + (r & 255); ap[mi] = A + (size_t)grow * K + kbeg + 8 * hi; }
#pragma unroll
    for (int ni = 0; ni < 2; ++ni) bp[ni] = Bt + (size_t)(ct * 64 + 32 * ni + l31) * K + kbeg + 8 * hi;
    f32x16 acc[2][2];
#pragma unroll
    for (int mi = 0; mi < 2; ++mi)
#pragma unroll
        for (int ni = 0; ni < 2; ++ni)
#pragma unroll
            for (int i = 0; i < 16; ++i) acc[mi][ni][i] = 0.f;
    for (int k0 = 0; k0 < ksl; k0 += 128) {
        bf16x8 fa[8][2], fb[8][2];
#pragma unroll
        for (int q = 0; q < 8; ++q) { fa[q][0] = *(const bf16x8*)(ap[0] + k0 + 16 * q); fa[q][1] = *(const bf16x8*)(ap[1] + k0 + 16 * q); fb[q][0] = *(const bf16x8*)(bp[0] + k0 + 16 * q); fb[q][1] = *(const bf16x8*)(bp[1] + k0 + 16 * q); }
#pragma unroll
        for (int q = 0; q < 8; ++q) { acc[0][0] = MFMA32(fa[q][0], fb[q][0], acc[0][0]); acc[0][1] = MFMA32(fa[q][0], fb[q][1], acc[0][1]); acc[1][0] = MFMA32(fa[q][1], fb[q][0], acc[1][0]); acc[1][1] = MFMA32(fa[q][1], fb[q][1], acc[1][1]); }
    }
    float* red = (float*)shm + wv * 4096;
#pragma unroll
    for (int mi = 0; mi < 2; ++mi)
#pragma unroll
        for (int ni = 0; ni < 2; ++ni)
#pragma unroll
            for (int i = 0; i < 16; ++i) red[(32 * mi + (i & 3) + 8 * (i >> 2) + 4 * hi) * 64 + 32 * ni + l31] = acc[mi][ni][i];
    __syncthreads();
    {
        const int r = tid >> 3, cg = tid & 7;
        const float* src = (const float*)shm + r * 64 + cg * 8;
        f32x4 s0 = *(const f32x4*)src, s1 = *(const f32x4*)(src + 4);
#pragma unroll
        for (int w = 1; w < 8; ++w) { s0 += *(const f32x4*)(src + w * 4096); s1 += *(const f32x4*)(src + w * 4096 + 4); }
        float v[8] = {s0[0], s0[1], s0[2], s0[3], s1[0], s1[1], s1[2], s1[3]};
        const int cr = rt * 64 + r; const int b = cr >> 8, tall = cr & 255; const int row = b * TPB + tall; const int c0 = ct * 64 + cg * 8;
        const ColVec cv = load_colvec(E, E.wsp, E.l, 4, c0);
        const float rstd = (E.mode <= 2) ? row_rstd(E, E.wsp, E.l, row) : 0.f;
        float ss = emit8(E, E.wsp, E.l, row, b, tall, true, c0, v, cv, rstd);
        if (E.mode == 3) { ss += __shfl_xor(ss, 1); ss += __shfl_xor(ss, 2); ss += __shfl_xor(ss, 4);
            if (cg == 0) rowsq_out_ptr(E, E.wsp, E.l)[(size_t)row * 16 + ct] = ss; }
    }
    __syncthreads();
}

DI void mini_gemm_seq1024(const Epi& E, const bf16_t* A, const bf16_t* Bt, int mt0, int nmt, int G, unsigned char* shm, int tid) {
    if (mt0 >= nmt) return;
    constexpr int K = 1024;
    const int wv = tid >> 6, lane = tid & 63, l31 = lane & 31, hi = lane >> 5;
    const int kbeg = wv * 128;
    bf16x8 fa[8][2], fb[8][2];
#define MINI_LOAD(mt_) do { const int pm_ = mini_perm(mt_); const int rt_ = pm_ & 15, ct_ = pm_ >> 4; \
        _Pragma("unroll") for (int mi = 0; mi < 2; ++mi) { const int r_ = rt_ * 64 + 32 * mi + l31; const bf16_t* ap_ = A + (size_t)((r_ >> 8) * TPB + (r_ & 255)) * K + kbeg + 8 * hi; \
            _Pragma("unroll") for (int q = 0; q < 8; ++q) fa[q][mi] = *(const bf16x8*)(ap_ + 16 * q); } \
        _Pragma("unroll") for (int ni = 0; ni < 2; ++ni) { const bf16_t* bp_ = Bt + (size_t)(ct_ * 64 + 32 * ni + l31) * K + kbeg + 8 * hi; \
            _Pragma("unroll") for (int q = 0; q < 8; ++q) fb[q][ni] = *(const bf16x8*)(bp_ + 16 * q); } } while (0)
    MINI_LOAD(mt0);
    for (int mt = mt0; mt < nmt; mt += G) {
        const int pmt = mini_perm(mt); const int rt = pmt & 15, ct = pmt >> 4;
        f32x16 acc[2][2];
#pragma unroll
        for (int mi = 0; mi < 2; ++mi)
#pragma unroll
            for (int ni = 0; ni < 2; ++ni)
#pragma unroll
                for (int i = 0; i < 16; ++i) acc[mi][ni][i] = 0.f;
#pragma unroll
        for (int q = 0; q < 8; ++q) { acc[0][0] = MFMA32(fa[q][0], fb[q][0], acc[0][0]); acc[0][1] = MFMA32(fa[q][0], fb[q][1], acc[0][1]); acc[1][0] = MFMA32(fa[q][1], fb[q][0], acc[1][0]); acc[1][1] = MFMA32(fa[q][1], fb[q][1], acc[1][1]); }
        float* red = (float*)shm + wv * 4096;
#pragma unroll
        for (int mi = 0; mi < 2; ++mi)
#pragma unroll
            for (int ni = 0; ni < 2; ++ni)
#pragma unroll
                for (int i = 0; i < 16; ++i) red[(32 * mi + (i & 3) + 8 * (i >> 2) + 4 * hi) * 64 + 32 * ni + l31] = acc[mi][ni][i];
        if (mt + G < nmt) MINI_LOAD(mt + G);
        __syncthreads();
        {
            const int r = tid >> 3, cg = tid & 7;
            const float* src = (const float*)shm + r * 64 + cg * 8;
            f32x4 s0 = *(const f32x4*)src, s1 = *(const f32x4*)(src + 4);
#pragma unroll
            for (int w = 1; w < 8; ++w) { s0 += *(const f32x4*)(src + w * 4096); s1 += *(const f32x4*)(src + w * 4096 + 4); }
            float v[8] = {s0[0], s0[1], s0[2], s0[3], s1[0], s1[1], s1[2], s1[3]};
            const int cr = rt * 64 + r; const int b = cr >> 8, tall = cr & 255; const int row = b * TPB + tall; const int c0 = ct * 64 + cg * 8;
            const ColVec cv = load_colvec(E, E.wsp, E.l, 4, c0);
            const float rstd = (E.mode <= 2) ? row_rstd(E, E.wsp, E.l, row) : 0.f;
            float ss = emit8(E, E.wsp, E.l, row, b, tall, true, c0, v, cv, rstd);
            if (E.mode == 3) { ss += __shfl_xor(ss, 1); ss += __shfl_xor(ss, 2); ss += __shfl_xor(ss, 4);
                if (cg == 0) rowsq_out_ptr(E, E.wsp, E.l)[(size_t)row * 16 + ct] = ss; }
        }
        __syncthreads();
    }
#undef MINI_LOAD
}

DI bf16x8 pack8(const f32x16& x, int s) {
    u32x4 p; p.x = pk2(x[8 * s], x[8 * s + 1]); p.y = pk2(x[8 * s + 2], x[8 * s + 3]); p.z = pk2(x[8 * s + 4], x[8 * s + 5]); p.w = pk2(x[8 * s + 6], x[8 * s + 7]);
    return __builtin_bit_cast(bf16x8, p);
}
DI bool softmax_tile(f32x16& s0, f32x16& s1, f32x16& negm, float& mref, float& l, const bool first, float& alpha) {
    float mx = fmaxf(s0[0], s1[0]);
#pragma unroll
    for (int i = 1; i < 16; ++i) mx = fmaxf(fmaxf(mx, s0[i]), s1[i]);
    mx = fmaxf(mx, __shfl_xor(mx, 32));
    const bool resc = first || (__builtin_amdgcn_ballot_w64(mx > 8.0f) != 0ull);
    alpha = 1.0f;
    if (resc) {
        const float delta = first ? mx : fmaxf(mx, 0.f);
        mref += delta;
        const float nm = -mref;
#pragma unroll
        for (int i = 0; i < 16; ++i) { negm[i] = nm; s0[i] -= delta; s1[i] -= delta; }
        alpha = __builtin_amdgcn_exp2f(-delta);
        l *= alpha;
    }
    float sum = 0.f;
#pragma unroll
    for (int i = 0; i < 16; ++i) { s0[i] = __builtin_amdgcn_exp2f(s0[i]); sum += s0[i]; }
#pragma unroll
    for (int i = 0; i < 16; ++i) { s1[i] = __builtin_amdgcn_exp2f(s1[i]); sum += s1[i]; }
    l += sum;
    return resc;
}

template <bool ALLOW_NA> DI void na_item(const P& p, unsigned char* shm, int wv, int j, unsigned item, int lane) {
    const bf16_t* QK = (const bf16_t*)(p.ws + OFF_QK);
    const bf16_t* VT = (const bf16_t*)(p.ws + OFF_VT);
    bf16_t* CAT = (bf16_t*)(p.ws + OFF_CAT);
    const int l31 = lane & 31, hi = lane >> 5;
    int b, h, qrow, ntiles, r = 0, qc = 0; bool na;
    if (ALLOW_NA && item < 4096u) { na = true; const int half = item & 1; h = (item >> 1) & 7; r = (item >> 4) & 63; b = item >> 10; qc = half * 32 + l31; qrow = b * TPB + 256 + r * 64 + qc; ntiles = 12; }
    else { const int it = item - 4096; na = false; const int qb = it & 7; h = (it >> 3) & 7; b = it >> 6; qrow = b * TPB + qb * 32 + l31; ntiles = 4; }
    bf16x8 qf[4];
#pragma unroll
    for (int c = 0; c < 4; ++c) qf[c] = *(const bf16x8*)(QK + (size_t)qrow * 1024 + h * 64 + 16 * c + 8 * hi);
    const int rs = min(max(r - 4, 0), 56), cs = min(max(qc - 8, 0), 48);
    const bf16_t* vbase = VT + (size_t)((b * 8 + h) * 64) * TPB;
    const float* rpb = p.in[12] + (size_t)(j * 8 + h) * 15 * 31;
    float* tab = (float*)(shm + (size_t)wv * 8192);
    if (na) {
        for (int idx = lane; idx < 465; idx += 64) tab[(idx / 31) * 128 + 48 + idx % 31] = rpb[idx] * LOG2E;
        __builtin_amdgcn_wave_barrier();
    }
    f32x16 o[2]; float m = 0.f, l = 0.f;
#pragma unroll
    for (int d = 0; d < 2; ++d)
#pragma unroll
        for (int i = 0; i < 16; ++i) o[d][i] = 0.f;
#define NA_POS0(tt_) ((na && (tt_) < 8) ? 256 + (rs + (tt_)) * 64 : (na ? ((tt_) - 8) * 64 : (tt_) * 64))
#define NA_LOADK(KF, tt_) do { const int p0_ = NA_POS0(tt_); const bf16_t* kp_ = QK + (size_t)(b * TPB + p0_ + l31) * 1024 + 512 + h * 64 + 8 * hi; \
        _Pragma("unroll") for (int kb = 0; kb < 2; ++kb) _Pragma("unroll") for (int c = 0; c < 4; ++c) KF[kb][c] = *(const bf16x8*)(kp_ + (size_t)kb * 32 * 1024 + 16 * c); } while (0)
#define NA_LOADV(VF, tt_) do { const int p0_ = NA_POS0(tt_); const bf16_t* vp_ = vbase + (size_t)l31 * TPB + p0_ + 8 * hi; \
        _Pragma("unroll") for (int d = 0; d < 2; ++d) _Pragma("unroll") for (int q4 = 0; q4 < 4; ++q4) VF[d][q4] = *(const bf16x8*)(vp_ + (size_t)32 * d * TPB + 16 * q4); } while (0)
#define NA_LOADV1(VF, d_, tt_) do { const int p0_ = NA_POS0(tt_); const bf16_t* vp_ = vbase + (size_t)l31 * TPB + p0_ + 8 * hi; \
        _Pragma("unroll") for (int q4 = 0; q4 < 4; ++q4) VF[q4] = *(const bf16x8*)(vp_ + (size_t)32 * (d_) * TPB + 16 * q4); } while (0)
    bf16x8 kf[2][4], vf[2][4], nkf[2][4], nvf0[4];
    NA_LOADK(kf, 0); NA_LOADV1(vf[0], 0, 0);
    for (int tt = 0; tt < ntiles; ++tt) {
        const bool masked = na && tt < 8;
        NA_LOADV1(vf[1], 1, tt);
        if (tt + 1 < ntiles) { NA_LOADK(nkf, tt + 1); NA_LOADV1(nvf0, 0, tt + 1); }
        f32x16 s[2];
        { const float nm = -m;
#pragma unroll
          for (int i = 0; i < 16; ++i) { s[0][i] = nm; s[1][i] = nm; } }
#pragma unroll
        for (int kb = 0; kb < 2; ++kb) {
#pragma unroll
            for (int c = 0; c < 4; ++c) s[kb] = MFMA32(kf[kb][c], qf[c], s[kb]);
        }
        if (masked) {
            const float* trow = tab + (rs + tt - r + 7) * 128 + 63 - qc + 4 * hi;
#pragma unroll
            for (int kb = 0; kb < 2; ++kb)
#pragma unroll
                for (int i = 0; i < 16; ++i) {
                    const int kc = 32 * kb + (i & 3) + 8 * (i >> 2) + 4 * hi;
                    const bool valid = (kc >= cs) && (kc < cs + 16);
                    s[kb][i] = valid ? s[kb][i] + trow[32 * kb + (i & 3) + 8 * (i >> 2)] : -1e30f;
                }
        }
        {
            float mx = fmaxf(s[0][0], s[1][0]);
#pragma unroll
            for (int i = 1; i < 16; ++i) mx = fmaxf(fmaxf(mx, s[0][i]), s[1][i]);
            mx = fmaxf(mx, __shfl_xor(mx, 32));
            if (tt == 0 || (__builtin_amdgcn_ballot_w64(mx > 8.0f) != 0ull)) {
                const float delta = (tt == 0) ? mx : fmaxf(mx, 0.f);
                m += delta;
#pragma unroll
                for (int i = 0; i < 16; ++i) { s[0][i] -= delta; s[1][i] -= delta; }
                const float alpha = __builtin_amdgcn_exp2f(-delta);
                l *= alpha;
#pragma unroll
                for (int d = 0; d < 2; ++d)
#pragma unroll
                    for (int i = 0; i < 16; ++i) o[d][i] *= alpha;
            }
            float sum = 0.f;
#pragma unroll
            for (int i = 0; i < 16; ++i) { s[0][i] = __builtin_amdgcn_exp2f(s[0][i]); sum += s[0][i]; }
#pragma unroll
            for (int i = 0; i < 16; ++i) { s[1][i] = __builtin_amdgcn_exp2f(s[1][i]); sum += s[1][i]; }
            l += sum;
        }
#pragma unroll
        for (int kb = 0; kb < 2; ++kb)
#pragma unroll
            for (int s2 = 0; s2 < 2; ++s2) {
                const bf16x8 pf = pack8(s[kb], s2);
#pragma unroll
                for (int d = 0; d < 2; ++d) o[d] = MFMA32(vf[d][2 * kb + s2], pf, o[d]);
            }
        if (tt + 1 < ntiles) {
#pragma unroll
            for (int kb = 0; kb < 2; ++kb)
#pragma unroll
                for (int c = 0; c < 4; ++c) { kf[kb][c] = nkf[kb][c]; if (kb == 0) vf[0][c] = nvf0[c]; }
        }
    }
#undef NA_LOADK
#undef NA_LOADV
#undef NA_LOADV1
#undef NA_POS0
    const float inv = 1.0f / (l + __shfl_xor(l, 32));
    bf16_t* op = CAT + (size_t)qrow * 1024 + 512 + h * 64;
#pragma unroll
    for (int d = 0; d < 2; ++d)
#pragma unroll
        for (int g = 0; g < 4; ++g) { u32x2 w; w.x = pk2(o[d][4 * g] * inv, o[d][4 * g + 1] * inv); w.y = pk2(o[d][4 * g + 2] * inv, o[d][4 * g + 3] * inv);
            *(u32x2*)(op + 32 * d + 8 * g + 4 * hi) = w; }
}

DI void na_half(const unsigned char* Kh, const unsigned char* Vh, const int sw, const int hi, const bf16x8 (&qf)[4], f32x16& o0, f32x16& o1, float& m, float& lsum,
                const bool masked, const bool first, const float rowval, const int qc) {
    f32x16 s0, s1;
    { const float nm = -m;
#pragma unroll
      for (int i = 0; i < 16; ++i) { s0[i] = nm; s1[i] = nm; } }
#pragma unroll
    for (int c = 0; c < 4; ++c) { const bf16x8 kf = *(const bf16x8*)(Kh + (((2 * c + hi) ^ sw) << 4)); s0 = MFMA32(kf, qf[c], s0); }
#pragma unroll
    for (int c = 0; c < 4; ++c) { const bf16x8 kf = *(const bf16x8*)(Kh + 4096 + (((2 * c + hi) ^ sw) << 4)); s1 = MFMA32(kf, qf[c], s1); }
    if (masked) {
        const int cs = min(max(qc - 8, 0), 48);
        int ib = (4 * hi - qc + 15) * 4; asm volatile("" : "+v"(ib));
        int rel = cs - 4 * hi; asm volatile("" : "+v"(rel));
#pragma unroll
        for (int i = 0; i < 16; ++i) {
            const int kcc = (i & 3) + 8 * (i >> 2);
            const float b0 = __int_as_float(__builtin_amdgcn_ds_bpermute(ib + 4 * kcc, __float_as_int(rowval)));
            const float b1 = __int_as_float(__builtin_amdgcn_ds_bpermute(ib + 4 * (kcc + 32), __float_as_int(rowval)));
            s0[i] = ((unsigned)(kcc - rel) < 16u) ? s0[i] + b0 : -1e30f;
            s1[i] = ((unsigned)(kcc + 32 - rel) < 16u) ? s1[i] + b1 : -1e30f;
        }
    }
    float mx = fmaxf(s0[0], s1[0]);
#pragma unroll
    for (int i = 1; i < 16; ++i) mx = fmaxf(fmaxf(mx, s0[i]), s1[i]);
    mx = fmaxf(mx, __shfl_xor(mx, 32));
    if (first || (__builtin_amdgcn_ballot_w64(mx > 8.0f) != 0ull)) {
        const float delta = first ? mx : fmaxf(mx, 0.f);
        m += delta;
#pragma unroll
        for (int i = 0; i < 16; ++i) { s0[i] -= delta; s1[i] -= delta; }
        const float alpha = __builtin_amdgcn_exp2f(-delta);
        lsum *= alpha;
#pragma unroll
        for (int i = 0; i < 16; ++i) { o0[i] *= alpha; o1[i] *= alpha; }
    }
    float sum = 0.f;
#pragma unroll
    for (int i = 0; i < 16; ++i) { s0[i] = __builtin_amdgcn_exp2f(s0[i]); sum += s0[i]; }
#pragma unroll
    for (int i = 0; i < 16; ++i) { s1[i] = __builtin_amdgcn_exp2f(s1[i]); sum += s1[i]; }
    lsum += sum;
#pragma unroll
    for (int s2 = 0; s2 < 2; ++s2) {
        const bf16x8 pf = pack8(s0, s2);
        const bf16x8 v0 = *(const bf16x8*)(Vh + (((2 * s2 + hi) ^ sw) << 4)), v1 = *(const bf16x8*)(Vh + 4096 + (((2 * s2 + hi) ^ sw) << 4));
        o0 = MFMA32(v0, pf, o0); o1 = MFMA32(v1, pf, o1);
    }
#pragma unroll
    for (int s2 = 0; s2 < 2; ++s2) {
        const bf16x8 pf = pack8(s1, s2);
        const bf16x8 v0 = *(const bf16x8*)(Vh + (((4 + 2 * s2 + hi) ^ sw) << 4)), v1 = *(const bf16x8*)(Vh + 4096 + (((4 + 2 * s2 + hi) ^ sw) << 4));
        o0 = MFMA32(v0, pf, o0); o1 = MFMA32(v1, pf, o1);
    }
}
DI void na_store(bf16_t* op, const f32x16& o0, const f32x16& o1, const float lsum, const int hi) {
    const float inv = 1.0f / (lsum + __shfl_xor(lsum, 32));
#pragma unroll
    for (int g = 0; g < 4; ++g) {
        u32x2 w; w.x = pk2(o0[4 * g] * inv, o0[4 * g + 1] * inv); w.y = pk2(o0[4 * g + 2] * inv, o0[4 * g + 3] * inv); *(u32x2*)(op + 8 * g + 4 * hi) = w;
        w.x = pk2(o1[4 * g] * inv, o1[4 * g + 1] * inv); w.y = pk2(o1[4 * g + 2] * inv, o1[4 * g + 3] * inv); *(u32x2*)(op + 32 + 8 * g + 4 * hi) = w; }
}
DI void na_block_item(const P& p, unsigned char* shm, int j, int item, int tid) {
    const bf16_t* QK = (const bf16_t*)(p.ws + OFF_QK);
    const bf16_t* VT = (const bf16_t*)(p.ws + OFF_VT);
    bf16_t* CAT = (bf16_t*)(p.ws + OFF_CAT);
    const int h = tid >> 6, lane = tid & 63, l31 = lane & 31, hi = lane >> 5;
    const int b = item >> 6, r = item & 63;
    const int rs = min(max(r - 4, 0), 56);
    const float* rpb = p.in[12] + (size_t)(j * 8 + h) * 15 * 31;
    bf16x8 qa[4], qb[4];
#pragma unroll
    for (int c = 0; c < 4; ++c) { qa[c] = *(const bf16x8*)(QK + (size_t)(b * TPB + 256 + r * 64 + l31) * 1024 + h * 64 + 16 * c + 8 * hi);
                                  qb[c] = *(const bf16x8*)(QK + (size_t)(b * TPB + 256 + r * 64 + 32 + l31) * 1024 + h * 64 + 16 * c + 8 * hi); }
    f32x16 oa0, oa1, ob0, ob1; float ma = 0.f, mb = 0.f, la = 0.f, lb = 0.f;
#pragma unroll
    for (int i = 0; i < 16; ++i) { oa0[i] = 0.f; oa1[i] = 0.f; ob0[i] = 0.f; ob1[i] = 0.f; }
    const int sw = (l31 >> 1) & 7;
    const unsigned char* Kh = shm + h * 8192 + l31 * 128;
    const unsigned char* Vh = shm + 65536 + h * 8192 + l31 * 128;
    for (int tt = 0; tt < 12; ++tt) {
        const bool masked = tt < 8;
        const int pos0 = masked ? 256 + (rs + tt) * 64 : (tt - 8) * 64;
        __syncthreads();
        {
            int tl = tid; asm volatile("" : "+v"(tl));
            const int krow = tl >> 6, kcb = tl & 63;
            const int kdst = (kcb >> 3) * 8192 + krow * 128;
            const int vrow = tl >> 3, vch = tl & 7;
            const int vdst = 65536 + vrow * 128 + ((vch ^ ((vrow >> 1) & 7)) << 4);
            const bf16_t* ks = QK + (size_t)(b * TPB + pos0 + krow) * 1024 + 512 + kcb * 8;
            const bf16_t* vs = VT + (size_t)((b * 8) * 64 + vrow) * TPB + pos0 + vch * 8;
            u32x4 tk[8], tv[8];
#pragma unroll
            for (int i = 0; i < 8; ++i) tk[i] = *(const u32x4*)(ks + (size_t)i * 8 * 1024);
#pragma unroll
            for (int i = 0; i < 8; ++i) tv[i] = *(const u32x4*)(vs + (size_t)i * 64 * TPB);
#pragma unroll
            for (int i = 0; i < 8; ++i) { const int row = krow + 8 * i; *(u32x4*)(shm + kdst + i * 1024 + (((kcb & 7) ^ ((row >> 1) & 7)) << 4)) = tk[i]; }
#pragma unroll
            for (int i = 0; i < 8; ++i) *(u32x4*)(shm + vdst + i * 8192) = tv[i];
        }
        __syncthreads();
        float rowval = 0.f;
        if (masked) rowval = rpb[(rs + tt - r + 7) * 31 + min(lane, 30)] * LOG2E;
        __builtin_amdgcn_sched_barrier(0);
        na_half(Kh, Vh, sw, hi, qa, oa0, oa1, ma, la, masked, tt == 0, rowval, l31);
        __builtin_amdgcn_sched_barrier(0);
        na_half(Kh, Vh, sw, hi, qb, ob0, ob1, mb, lb, masked, tt == 0, rowval, 32 + l31);
        __builtin_amdgcn_sched_barrier(0);
    }
    {
        int t2 = tid; asm volatile("" : "+v"(t2));
        const int h2 = t2 >> 6, l2 = t2 & 31, hi2 = (t2 >> 5) & 1;
        bf16_t* op = CAT + (size_t)(b * TPB + 256 + r * 64 + l2) * 1024 + 512 + h2 * 64;
        na_store(op, oa0, oa1, la, hi2);
        na_store(op + (size_t)32 * 1024, ob0, ob1, lb, hi2);
    }
    __syncthreads();
}

constexpr int DA_ROW = 144, DA_KBYTES = 2 * 64 * DA_ROW, DA_STAGE = DA_KBYTES + 128 * DA_ROW;
DI void diff_item(const P& p, unsigned char* shm, int l, int bh, int qrow0, int nkt, float lam, float lam_init, int tid) {
    const bf16_t* QK = (const bf16_t*)(p.ws + OFF_QK);
    const bf16_t* VT = (const bf16_t*)(p.ws + OFF_VT);
    bf16_t* CAT = (bf16_t*)(p.ws + OFF_CAT);
    const int j = l >> 1;
    const int wv = tid >> 6, lane = tid & 63, l31 = lane & 31, hi = lane >> 5, sub = wv >> 2, qw = wv & 3;
    const int b = bh >> 3, h = bh & 7;
    const int qrow = qrow0 + 32 * qw + l31;
    bf16x8 qf[4];
#pragma unroll
    for (int c = 0; c < 4; ++c) qf[c] = *(const bf16x8*)(QK + (size_t)qrow * 2048 + h * 128 + sub * 64 + 16 * c + 8 * hi);
    const bf16_t* ksrc[2]; const bf16_t* vsrc[2]; int kdst[2], vdst[2];
#pragma unroll
    for (int i = 0; i < 2; ++i) { const int id = tid + 512 * i; const int row = id >> 4, cb = id & 15;
        ksrc[i] = QK + (size_t)(b * TPB + row) * 2048 + 1024 + h * 128 + cb * 8; kdst[i] = ((cb >> 3) * 64 + row) * DA_ROW + (cb & 7) * 16;
        const int d = id >> 3, pc = id & 7;
        vsrc[i] = VT + (size_t)(bh * 128 + d) * TPB + pc * 8; vdst[i] = DA_KBYTES + d * DA_ROW + pc * 16; }
    u32x4 pre[4];
    {
        u32x4 pre1[4];
#pragma unroll
        for (int i = 0; i < 2; ++i) { pre[i] = *(const u32x4*)(ksrc[i]); pre[2 + i] = *(const u32x4*)(vsrc[i]); pre1[i] = *(const u32x4*)(ksrc[i] + (size_t)64 * 2048); pre1[2 + i] = *(const u32x4*)(vsrc[i] + 64); }
#pragma unroll
        for (int i = 0; i < 2; ++i) { *(u32x4*)(shm + kdst[i]) = pre[i]; *(u32x4*)(shm + vdst[i]) = pre[2 + i]; *(u32x4*)(shm + DA_STAGE + kdst[i]) = pre1[i]; *(u32x4*)(shm + DA_STAGE + vdst[i]) = pre1[2 + i]; }
    }
    __syncthreads();
    f32x16 o[4]; float m = 0.f, lsum = 0.f;
#pragma unroll
    for (int d = 0; d < 4; ++d)
#pragma unroll
        for (int i = 0; i < 16; ++i) o[d][i] = 0.f;
    const int koff = sub * 64 * DA_ROW + l31 * DA_ROW + 16 * hi;
    const int voff = DA_KBYTES + l31 * DA_ROW + 16 * hi;
    f32x16 s[2], sn[2];
#pragma unroll
    for (int kb = 0; kb < 2; ++kb)
#pragma unroll
        for (int c = 0; c < 4; ++c) { const bf16x8 kf = *(const bf16x8*)(shm + koff + 32 * kb * DA_ROW + 32 * c); if (c == 0) { _Pragma("unroll") for (int i = 0; i < 16; ++i) s[kb][i] = 0.f; } s[kb] = MFMA32(kf, qf[c], s[kb]); }
    float mx = fmaxf(s[0][0], s[1][0]);
#pragma unroll
    for (int i = 1; i < 16; ++i) mx = fmaxf(fmaxf(mx, s[0][i]), s[1][i]);
    mx = fmaxf(mx, __shfl_xor(mx, 32));
    int st_cur = 0, st_nxt = DA_STAGE, st_ld = 2 * DA_STAGE;
    for (int kt = 0; kt < nkt; ++kt) {
        const bool more = (kt + 2 < nkt);
        if (more) {
#pragma unroll
            for (int i = 0; i < 2; ++i) { pre[i] = *(const u32x4*)(ksrc[i] + (size_t)(kt + 2) * 64 * 2048); pre[2 + i] = *(const u32x4*)(vsrc[i] + (kt + 2) * 64); }
        }
        if (kt == 0 || (__builtin_amdgcn_ballot_w64(mx > 8.0f) != 0ull)) {
            const float delta = (kt == 0) ? mx : fmaxf(mx, 0.f);
            m += delta;
#pragma unroll
            for (int i = 0; i < 16; ++i) { s[0][i] -= delta; s[1][i] -= delta; }
            const float alpha = __builtin_amdgcn_exp2f(-delta);
            lsum *= alpha;
#pragma unroll
            for (int d = 0; d < 4; ++d)
#pragma unroll
                for (int i = 0; i < 16; ++i) o[d][i] *= alpha;
        }
        if (sub == 0) __builtin_amdgcn_s_setprio(1);
        const unsigned char* Kn = shm + st_nxt + koff;
        const unsigned char* Vc = shm + st_cur + voff;
        bf16x8 kf[8];
#pragma unroll
        for (int kb = 0; kb < 2; ++kb)
#pragma unroll
            for (int c = 0; c < 4; ++c) kf[kb * 4 + c] = *(const bf16x8*)(Kn + 32 * kb * DA_ROW + 32 * c);
        { const float nm = -m;
#pragma unroll
          for (int i = 0; i < 16; ++i) { sn[0][i] = nm; sn[1][i] = nm; } }
        __builtin_amdgcn_sched_barrier(0);
#pragma unroll
        for (int kb = 0; kb < 2; ++kb)
#pragma unroll
            for (int c = 0; c < 4; ++c) sn[kb] = MFMA32(kf[kb * 4 + c], qf[c], sn[kb]);
        float sum = 0.f;
#pragma unroll
        for (int i = 0; i < 16; ++i) { s[0][i] = __builtin_amdgcn_exp2f(s[0][i]); sum += s[0][i]; }
        const bf16x8 p00 = pack8(s[0], 0), p01 = pack8(s[0], 1);
        __builtin_amdgcn_sched_barrier(0);
        bf16x8 vf[8];
#pragma unroll
        for (int d = 0; d < 4; ++d) { vf[2 * d] = *(const bf16x8*)(Vc + 32 * d * DA_ROW); vf[2 * d + 1] = *(const bf16x8*)(Vc + 32 * d * DA_ROW + 32); }
        __builtin_amdgcn_sched_barrier(0);
#pragma unroll
        for (int d = 0; d < 4; ++d) { o[d] = MFMA32(vf[2 * d], p00, o[d]); o[d] = MFMA32(vf[2 * d + 1], p01, o[d]); }
#pragma unroll
        for (int i = 0; i < 16; ++i) { s[1][i] = __builtin_amdgcn_exp2f(s[1][i]); sum += s[1][i]; }
        lsum += sum;
        const bf16x8 p10 = pack8(s[1], 0), p11 = pack8(s[1], 1);
        __builtin_amdgcn_sched_barrier(0);
#pragma unroll
        for (int d = 0; d < 4; ++d) { vf[2 * d] = *(const bf16x8*)(Vc + 32 * d * DA_ROW + 64); vf[2 * d + 1] = *(const bf16x8*)(Vc + 32 * d * DA_ROW + 96); }
        __builtin_amdgcn_sched_barrier(0);
#pragma unroll
        for (int d = 0; d < 4; ++d) { o[d] = MFMA32(vf[2 * d], p10, o[d]); o[d] = MFMA32(vf[2 * d + 1], p11, o[d]); }
        __builtin_amdgcn_s_setprio(0);
        mx = fmaxf(sn[0][0], sn[1][0]);
#pragma unroll
        for (int i = 1; i < 16; ++i) mx = fmaxf(fmaxf(mx, sn[0][i]), sn[1][i]);
        mx = fmaxf(mx, __shfl_xor(mx, 32));
        if (more) {
#pragma unroll
            for (int i = 0; i < 2; ++i) { *(u32x4*)(shm + st_ld + kdst[i]) = pre[i]; *(u32x4*)(shm + st_ld + vdst[i]) = pre[2 + i]; }
        }
        __syncthreads();
        s[0] = sn[0]; s[1] = sn[1];
        const int t_ = st_cur; st_cur = st_nxt; st_nxt = st_ld; st_ld = t_;
    }
    const float inv = 1.0f / (lsum + __shfl_xor(lsum, 32));
    f32x4* xch = (f32x4*)shm;
    if (sub == 1) {
#pragma unroll
        for (int d = 0; d < 4; ++d)
#pragma unroll
            for (int g = 0; g < 4; ++g) xch[(qw * 16 + d * 4 + g) * 64 + lane] = (f32x4){o[d][4 * g] * inv, o[d][4 * g + 1] * inv, o[d][4 * g + 2] * inv, o[d][4 * g + 3] * inv};
    }
    __syncthreads();
    if (sub == 0) {
        int lq = l; asm volatile("" : "+s"(lq));
        const float lam2 = ((const float*)(p.ws + OFF_LAM))[lq >> 1];
        const float lam_init2 = 0.8f - 0.6f * expf(-0.3f * (float)lq);
        float ss = 0.f;
#pragma unroll
        for (int d = 0; d < 4; ++d)
#pragma unroll
            for (int g = 0; g < 4; ++g) { const f32x4 o2 = xch[(qw * 16 + d * 4 + g) * 64 + lane];
#pragma unroll
                for (int i = 0; i < 4; ++i) { const float y = o[d][4 * g + i] * inv - lam2 * o2[i]; o[d][4 * g + i] = y; ss += y * y; } }
        ss += __shfl_xor(ss, 32);
        const float rn = rsqrtf(ss * (1.0f / 128.0f) + 1e-5f) * (1.0f - lam_init2);
        const float* sg = p.in[19] + j * 128;
        bf16_t* op = CAT + (size_t)qrow * 1024 + h * 128;
#pragma unroll
        for (int d = 0; d < 4; ++d)
#pragma unroll
            for (int g = 0; g < 4; ++g) { const int d0 = 32 * d + 8 * g + 4 * hi; const f32x4 gg = *(const f32x4*)(sg + d0);
                u32x2 w; w.x = pk2(o[d][4 * g] * rn * gg[0], o[d][4 * g + 1] * rn * gg[1]); w.y = pk2(o[d][4 * g + 2] * rn * gg[2], o[d][4 * g + 3] * rn * gg[3]);
                *(u32x2*)(op + d0) = w; }
    }
    __syncthreads();
}

DI void transpose_item(const float* W, int ldw, bf16_t* WT, int K, int item, int nblk, float* scr, int lane) {
    const int kb = item / nblk, nb = item % nblk, k0 = 64 * kb, n0 = 32 * nb;
#pragma unroll 8
    for (int i = 0; i < 32; ++i) { const int kk = 2 * i + (lane >> 5); scr[kk * 33 + (lane & 31)] = __builtin_nontemporal_load(W + (size_t)(k0 + kk) * ldw + n0 + (lane & 31)); }
    __builtin_amdgcn_wave_barrier();
    const int c = lane & 7;
#pragma unroll
    for (int jx = 0; jx < 4; ++jx) { const int n = (lane >> 3) + 8 * jx; const float* s = scr + (8 * c) * 33 + n;
        u32x4 o; o.x = pk2(s[0 * 33], s[1 * 33]); o.y = pk2(s[2 * 33], s[3 * 33]); o.z = pk2(s[4 * 33], s[5 * 33]); o.w = pk2(s[6 * 33], s[7 * 33]);
        *(u32x4*)(WT + (size_t)(n0 + n) * K + k0 + 8 * c) = o; }
    __builtin_amdgcn_wave_barrier();
}

DI void phase0(const P& p, unsigned char* shm, int tid) {
    float* ldsf = (float*)shm;
    const int wv = tid >> 6, lane = tid & 63;
    const int G = gridDim.x, blk = blockIdx.x;
    float* MOD = (float*)(p.ws + OFF_MOD);
    {
        for (int i = tid; i < 5120; i += 512) { const int r = i >> 10, k = i & 1023; const float v = r < 4 ? p.in[1][r * 1024 + k] : p.in[3][k]; ldsf[i] = v / (1.0f + expf(-v)); }
        __syncthreads();
        float* red = ldsf + 5120;
        const int col32 = lane & 31, ksub = lane >> 5;
        for (int item = blk; item < 768; item += G) {
            const int l = item / 192, n0 = (item % 192) * 32;
            const float* W = p.in[4] + (size_t)l * 1024 * 6144 + n0 + col32;
            float a0 = 0.f, a1 = 0.f, a2 = 0.f, a3 = 0.f, a4 = 0.f;
#pragma unroll 8
            for (int i = 0; i < 64; ++i) { const int k = wv * 128 + 2 * i + ksub; const float w = __builtin_nontemporal_load(W + (size_t)k * 6144);
                a0 += ldsf[k] * w; a1 += ldsf[1024 + k] * w; a2 += ldsf[2048 + k] * w; a3 += ldsf[3072 + k] * w; a4 += ldsf[4096 + k] * w; }
            a0 += __shfl_xor(a0, 32); a1 += __shfl_xor(a1, 32); a2 += __shfl_xor(a2, 32); a3 += __shfl_xor(a3, 32); a4 += __shfl_xor(a4, 32);
            if (lane < 32) { red[(wv * 5 + 0) * 32 + lane] = a0; red[(wv * 5 + 1) * 32 + lane] = a1; red[(wv * 5 + 2) * 32 + lane] = a2; red[(wv * 5 + 3) * 32 + lane] = a3; red[(wv * 5 + 4) * 32 + lane] = a4; }
            __syncthreads();
            if (tid < 160) { const int r = tid >> 5, cl = tid & 31; float s = 0.f;
#pragma unroll
                for (int w = 0; w < 8; ++w) s += red[(w * 5 + r) * 32 + cl];
                MOD[(size_t)(l * 5 + r) * 6144 + n0 + cl] = s + p.in[5][l * 6144 + n0 + cl]; }
            __syncthreads();
        }
    }
    {
        float* tile = ldsf; float* tabc = ldsf + 8192; float* tabs = ldsf + 8320;
        if (tid < 128) { tabc[tid] = cospif((float)tid * (1.0f / 64.0f)); tabs[tid] = sinpif((float)tid * (1.0f / 64.0f)); }
        for (int item = blk; item < 128; item += G) {
            const int jj = item >> 6, g = (item >> 4) & 3, k0 = (item & 15) * 64;
            __syncthreads();
#pragma unroll
            for (int i = 0; i < 16; ++i) { const int idx = tid + 512 * i; const int row = idx >> 7, col = idx & 127; tile[idx] = p.in[10][(size_t)jj * 1024 * 2048 + (size_t)(k0 + row) * 2048 + g * 128 + col]; }
            __syncthreads();
            const int c = tid >> 2, kq = tid & 3;
            float ac[16], as[16];
#pragma unroll
            for (int i = 0; i < 16; ++i) { ac[i] = 0.f; as[i] = 0.f; }
            for (int cp = 0; cp < 128; ++cp) { const int idx = (c * cp) & 127; const float tc = tabc[idx], ts = tabs[idx];
#pragma unroll
                for (int kk = 0; kk < 16; ++kk) { const float x = tile[(kq * 16 + kk) * 128 + cp]; ac[kk] += x * tc; as[kk] += x * ts; } }
            bf16_t* WT = (bf16_t*)(p.ws + OFF_WINAB) + (size_t)jj * 2560 * 1024;
            u32x4 w0, w1;
            w0.x = pk2(ac[0], ac[1]); w0.y = pk2(ac[2], ac[3]); w0.z = pk2(ac[4], ac[5]); w0.w = pk2(ac[6], ac[7]);
            w1.x = pk2(ac[8], ac[9]); w1.y = pk2(ac[10], ac[11]); w1.z = pk2(ac[12], ac[13]); w1.w = pk2(ac[14], ac[15]);
            u32x4* d0 = (u32x4*)(WT + (size_t)(g * 128 + c) * 1024 + k0 + kq * 16); d0[0] = w0; d0[1] = w1;
            w0.x = pk2(as[0], as[1]); w0.y = pk2(as[2], as[3]); w0.z = pk2(as[4], as[5]); w0.w = pk2(as[6], as[7]);
            w1.x = pk2(as[8], as[9]); w1.y = pk2(as[10], as[11]); w1.z = pk2(as[12], as[13]); w1.w = pk2(as[14], as[15]);
            u32x4* d1 = (u32x4*)(WT + (size_t)(512 + g * 128 + c) * 1024 + k0 + kq * 16); d1[0] = w0; d1[1] = w1;
        }
    }
    __syncthreads();
    {
        float* scr = ldsf + 8192 + wv * 2112;
        unsigned* t1ctr = (unsigned*)(p.ws + OFF_CTL) + 16;
        for (;;) {
            unsigned itu = 0;
            if (lane == 0) itu = __hip_atomic_fetch_add(t1ctr, 1u, __ATOMIC_RELAXED, __HIP_MEMORY_SCOPE_AGENT);
            const int chunk = __builtin_amdgcn_readfirstlane((int)itu);
            if (chunk >= 1536) break;
            for (int it = chunk * 15; it < chunk * 15 + 15; ++it) {
            int r = it; const float* W; int ldw, K, nblk; bf16_t* WT;
            if (r < 1536) { const int jj = r / 768; r %= 768; W = p.in[10] + (size_t)jj * 1024 * 2048 + 512; ldw = 2048; WT = (bf16_t*)(p.ws + OFF_WINAB) + ((size_t)jj * 2560 + 1024) * 1024; K = 1024; nblk = 48; }
            else if ((r -= 1536) < 1024) { const int jj = r / 512; r %= 512; W = p.in[11] + (size_t)jj * 1024 * 1024; ldw = 1024; WT = (bf16_t*)(p.ws + OFF_WOUTAB) + (size_t)jj * 1024 * 1024; K = 1024; nblk = 32; }
            else if ((r -= 1024) < 3072) { const int jj = r / 1536; r %= 1536; W = p.in[13] + (size_t)jj * 1024 * 3072; ldw = 3072; WT = (bf16_t*)(p.ws + OFF_WQKV) + (size_t)jj * 3072 * 1024; K = 1024; nblk = 96; }
            else if ((r -= 3072) < 1024) { const int jj = r / 512; r %= 512; W = p.in[14] + (size_t)jj * 1024 * 1024; ldw = 1024; WT = (bf16_t*)(p.ws + OFF_WOUTD) + (size_t)jj * 1024 * 1024; K = 1024; nblk = 32; }
            else if ((r -= 1024) < 8192) { const int ll = r / 2048; r %= 2048; W = p.in[8] + (size_t)ll * 1024 * 4096; ldw = 4096; WT = (bf16_t*)(p.ws + OFF_WMI) + (size_t)ll * 4096 * 1024; K = 1024; nblk = 128; }
            else { r -= 8192; const int ll = r / 2048; r %= 2048; W = p.in[9] + (size_t)ll * 4096 * 1024; ldw = 1024; WT = (bf16_t*)(p.ws + OFF_WMO) + (size_t)ll * 1024 * 4096; K = 4096; nblk = 32; }
            transpose_item(W, ldw, WT, K, r, nblk, scr, lane);
            }
        }
    }
    __syncthreads();
    {
        float* tab = ldsf;
        for (int i = tid; i < 4096; i += 512) tab[i] = cospif((float)i * (1.0f / 2048.0f));
        __syncthreads();
        bf16_t* D1 = (bf16_t*)(p.ws + OFF_D128);
        for (int idx = blk * 512 + tid; idx < 65536; idx += G * 512) {
            const int n = idx >> 8, k = idx & 255; const int mm = ((n & 127) * (k & 127)) & 127;
            const float c = tab[(32 * mm) & 4095], sn = tab[(32 * mm - 1024) & 4095];
            const float val = (n < 128) ? (k < 128 ? c : sn) : (k < 128 ? -sn : c);
            D1[idx] = bf1(val);
        }
        bf16_t* DC = (bf16_t*)(p.ws + OFF_DFTC);
        for (int row = blk; row < 256; row += G) {
            if (tid < 32) { const int n0 = tid * 8; float c8[8], s8[8];
#pragma unroll
                for (int e = 0; e < 8; ++e) { const int idx = (16 * row * (n0 + e)) & 4095; c8[e] = tab[idx]; s8[e] = -tab[(idx - 1024) & 4095]; }
                u32x4 w; w.x = pk2(c8[0], c8[1]); w.y = pk2(c8[2], c8[3]); w.z = pk2(c8[4], c8[5]); w.w = pk2(c8[6], c8[7]);
                *(u32x4*)(DC + (size_t)row * 512 + n0) = w;
                w.x = pk2(s8[0], s8[1]); w.y = pk2(s8[2], s8[3]); w.z = pk2(s8[4], s8[5]); w.w = pk2(s8[6], s8[7]);
                *(u32x4*)(DC + (size_t)row * 512 + 256 + n0) = w; }
        }
    }
    if (blk == G - 1) {
        float* rope = (float*)(p.ws + OFF_ROPE);
        for (int i = tid; i < 1024; i += 512) { const int pos = i >> 4, jf = i & 15; const float inv = powf(10000.0f, -(float)jf / 16.0f); const float ang = (float)pos * inv; rope[2 * i] = cosf(ang); rope[2 * i + 1] = sinf(ang); }
        if (tid < 2) { float s1 = 0.f, s2 = 0.f; for (int d = 0; d < 64; ++d) { s1 += p.in[15][tid * 64 + d] * p.in[16][tid * 64 + d]; s2 += p.in[17][tid * 64 + d] * p.in[18][tid * 64 + d]; }
            const float lam_init = 0.8f - 0.6f * expf(-0.3f * (float)(2 * tid + 1));
            ((float*)(p.ws + OFF_LAM))[tid] = expf(s1) - expf(s2) + lam_init; }
    }
}

DI void phase0b(const P& p, int tid) {
    const int wv = tid >> 6, lane = tid & 63;
    const int gw = blockIdx.x * 8 + wv, NGW = gridDim.x * 8;
    const float* MOD = (const float*)(p.ws + OFF_MOD);
    {
        bf16_t* XB = (bf16_t*)(p.ws + OFF_XB); float* RSQ = (float*)(p.ws + OFF_RSQ16);
        for (int row = gw; row < NROWS; row += NGW) {
            const int b = row / TPB, tall = row % TPB; const bool isctx = tall < 256; const int bsel = isctx ? 4 : b;
            const float* src = isctx ? p.in[2] + (size_t)(b * 256 + tall) * 1024 : p.in[0] + (size_t)(b * 4096 + tall - 256) * 1024;
            const float* sc = MOD + (size_t)bsel * 6144 + 1024;
            float ss = 0.f;
#pragma unroll
            for (int jj = 0; jj < 4; ++jj) { const int n = 4 * lane + 256 * jj; const f32x4 v = __builtin_nontemporal_load((const f32x4*)(src + n));
                const f32x4 gs = *(const f32x4*)(p.in[6] + n) * (*(const f32x4*)(sc + n) + 1.0f); const f32x4 y = v * gs;
                ss += (v[0] * v[0] + v[1] * v[1]) + (v[2] * v[2] + v[3] * v[3]);
                u32x2 w; w.x = pk2(y[0], y[1]); w.y = pk2(y[2], y[3]); *(u32x2*)(XB + (size_t)row * 1024 + n) = w; }
            ss = wave_sum(ss);
            if (lane < 16) RSQ[(size_t)row * 16 + lane] = (lane == 0) ? ss : 0.f;
        }
    }
    {
        for (int it = gw; it < 28672; it += NGW) {
            const bf16_t* wt; const float* sh; float* out; int ostride;
            if (it < 12288) { const int l = it / 3072, n = it % 3072; const int jj = l >> 1; const bool odd = l & 1; if (!odd && n >= 2560) continue;
                wt = odd ? (const bf16_t*)(p.ws + OFF_WQKV) + ((size_t)jj * 3072 + n) * 1024 : (const bf16_t*)(p.ws + OFF_WINAB) + ((size_t)jj * 2560 + n) * 1024;
                sh = MOD + (size_t)l * 5 * 6144; out = (float*)(p.ws + OFF_SWMIX) + (size_t)l * 5 * 3072 + n; ostride = 3072; }
            else { const int r = it - 12288; const int l = r / 4096, n = r % 4096;
                wt = (const bf16_t*)(p.ws + OFF_WMI) + ((size_t)l * 4096 + n) * 1024;
                sh = MOD + (size_t)l * 5 * 6144 + 3072; out = (float*)(p.ws + OFF_SWMLP) + (size_t)l * 5 * 4096 + n; ostride = 4096; }
            const u32x4 wa = *(const u32x4*)(wt + lane * 16), wb = *(const u32x4*)(wt + lane * 16 + 8);
            float wf[16];
            wf[0] = __uint_as_float(wa.x << 16); wf[1] = __uint_as_float(wa.x & 0xffff0000u); wf[2] = __uint_as_float(wa.y << 16); wf[3] = __uint_as_float(wa.y & 0xffff0000u);
            wf[4] = __uint_as_float(wa.z << 16); wf[5] = __uint_as_float(wa.z & 0xffff0000u); wf[6] = __uint_as_float(wa.w << 16); wf[7] = __uint_as_float(wa.w & 0xffff0000u);
            wf[8] = __uint_as_float(wb.x << 16); wf[9] = __uint_as_float(wb.x & 0xffff0000u); wf[10] = __uint_as_float(wb.y << 16); wf[11] = __uint_as_float(wb.y & 0xffff0000u);
            wf[12] = __uint_as_float(wb.z << 16); wf[13] = __uint_as_float(wb.z & 0xffff0000u); wf[14] = __uint_as_float(wb.w << 16); wf[15] = __uint_as_float(wb.w & 0xffff0000u);
#pragma unroll
            for (int r = 0; r < 5; ++r) { const float* s = sh + (size_t)r * 6144 + lane * 16; float a = 0.f;
#pragma unroll
                for (int q = 0; q < 4; ++q) { const f32x4 sv = *(const f32x4*)(s + 4 * q); a += sv[0] * wf[4 * q] + sv[1] * wf[4 * q + 1] + sv[2] * wf[4 * q + 2] + sv[3] * wf[4 * q + 3]; }
                a = wave_sum(a);
                if (lane == 0) out[(size_t)r * ostride] = a; }
        }
    }
}

__global__ __launch_bounds__(512, 2) void mega(P p) {
    extern __shared__ __attribute__((aligned(16))) unsigned char shm[];
    cg::grid_group grid = cg::this_grid();
    const int G = gridDim.x, blk = blockIdx.x;
    uint4& xb_words = *(uint4*)(shm + 131072);
    int wave_s = __builtin_amdgcn_readfirstlane((int)(threadIdx.x >> 6));
    if (threadIdx.x == 0) xb_words = make_uint4(0u, 0u, 0u, 0u);
    __syncthreads();
    (void)xcd_barrier_post((unsigned*)(p.ws + OFF_BAR), (volatile LAS unsigned*)&xb_words);
#define GRID_BARRIER() do { XcdBarrier xb_; unsigned z_ = 0u; asm volatile("" : "+s"(z_)); unsigned char* w_ = p.ws + z_; xb_.bar = (unsigned*)(w_ + OFF_BAR); xb_.x = xb_xcc_id(); xb_.st = (volatile LAS unsigned*)&xb_words; xcd_barrier(xb_, get_tid(wave_s)); } while (0)
    { asm volatile("" : "+s"(wave_s)); const int tid = get_tid(wave_s);
#ifndef NO_P0
    phase0(p, shm, tid);
#ifdef X_PRO_TWICE
    __syncthreads(); phase0(p, shm, tid);
#endif
#endif
    }
    grid.sync();
    { asm volatile("" : "+s"(wave_s)); const int tid = get_tid(wave_s);
#ifndef NO_P0
    phase0b(p, tid);
#endif
    }
    GRID_BARRIER();
    float* MOD = (float*)(p.ws + OFF_MOD);
    for (int ph = 0; ph < 24; ++ph) {
        asm volatile("" : "+s"(wave_s)); const int tid = get_tid(wave_s);
        const int l = ph / 6, s6 = ph % 6, j = l >> 1; const bool odd = (l & 1) != 0;
        const int s = (s6 == 2) ? 9 : (s6 < 2 ? s6 : s6 - 1);
        if (s == 9 && odd) continue;
        const int nops = (s == 1) ? (odd ? 0 : 1) : 1;
        for (int oi = 0; oi < nops; ++oi) {
            pg8::Gemm g; EpiPg8 EP; Epi& E = EP.E; int rot = 0, skip = 1;
            E.mode = 0; EP.perm = 1; E.perm = 1; E.l = l; E.s = s; E.wsp = p.ws; E.outp = p.out; E.in0 = p.in[0]; E.in2 = p.in[2]; E.in6 = p.in[6]; E.in7 = p.in[7];
            if (s == 0) {
                g.A = (const bf16_t*)(p.ws + OFF_XB); g.M = 16384; g.K = 1024;
                if (odd) { g.Bt = (const bf16_t*)(p.ws + OFF_WQKV) + (size_t)j * 3072 * 1024; g.N = 3072; E.mode = 1; }
                else { g.Bt = (const bf16_t*)(p.ws + OFF_WINAB) + (size_t)j * 2560 * 1024; g.N = 2560; E.mode = 0; g.M = NROWS; skip = 0; }
            } else if (s == 1) {
                skip = 0; g.A = (const bf16_t*)(p.ws + OFF_DFTC); g.Bt = (const bf16_t*)(p.ws + OFF_FTC); g.M = 256; g.N = 2048; g.K = 512; E.mode = 5;
            } else if (s == 9) {
                skip = 0; g.A = (const bf16_t*)(p.ws + OFF_TP); g.Bt = (const bf16_t*)(p.ws + OFF_D128); g.M = 65536; g.N = 256; g.K = 256; E.mode = 4;
            } else if (s == 2) {
                g.A = (const bf16_t*)(p.ws + OFF_CAT); g.Bt = (odd ? (const bf16_t*)(p.ws + OFF_WOUTD) : (const bf16_t*)(p.ws + OFF_WOUTAB)) + (size_t)j * 1024 * 1024; g.M = 16384; g.N = 1024; g.K = 1024;
                E.mode = 3;
            } else if (s == 3) {
                g.A = (const bf16_t*)(p.ws + OFF_XB); g.Bt = (const bf16_t*)(p.ws + OFF_WMI) + (size_t)l * 4096 * 1024; g.M = 16384; g.N = 4096; g.K = 1024;
                E.mode = 2;
            } else {
                g.A = (const bf16_t*)(p.ws + OFF_U); g.Bt = (const bf16_t*)(p.ws + OFF_WMO) + (size_t)l * 1024 * 4096; g.M = 16384; g.N = 1024; g.K = 4096;
                E.mode = 3;
            }
            pg8::StaticOrder S; S.init(g.M, g.N, G, (blk + rot) % G, skip);
            const bool has_mini = (s != 1 && s != 9 && (l < 3 || s == 0)) && !(s == 0 && !odd);
            const bool mini_first = ((blk >> 3) & 1) != 0;
            for (int pass = 0; pass < 2; ++pass) {
                if (has_mini && (pass == 0) == mini_first) {
                    const int nmt = 16 * (g.N >> 6);
                    const int tid3 = get_tid(wave_s);
                    if (g.K == 1024) mini_gemm_seq1024(E, g.A, g.Bt, (blk + 128) % G + ((l == 3 && s == 0) ? 256 : 0), nmt, G, shm, tid3);
                    else for (int mt = (blk + 128) % G; mt < nmt; mt += G) mini_gemm_tile(E, g.A, g.Bt, g.K, mt, shm, tid3);
                }
                if (pass == 0) {
                    const int tidg = get_tid(wave_s);
                    pg8::gemm_phase(( LAS unsigned char*)shm, g, S, EP, tidg);
                }
            }
        }
        if (s == 1 && !odd) {
            unsigned z2 = 0u; asm volatile("" : "+s"(z2)); unsigned char* w2 = p.ws + z2;
            const int tidf = get_tid(wave_s);
            for (int it = (blk + 248) % G; it < 512; it += G) fft_stage1_item(w2, it, tidf);
        }
        if (s == 1 || s == 9) {
            if (!odd) {
                unsigned* ctr = (unsigned*)(p.ws + OFF_CTL) + l;
                if (s == 1) { const int tidb = get_tid(wave_s); for (int bi = blk; bi < 256; bi += G) na_block_item(p, shm, j, bi, tidb); }
                const int tidn = get_tid(wave_s);
                const int lane = tidn & 63;
                for (;;) {
                    unsigned it = 0;
                    if (lane == 0) it = __hip_atomic_fetch_add(ctr, 1u, __ATOMIC_RELAXED, __HIP_MEMORY_SCOPE_AGENT);
                    it = (unsigned)__builtin_amdgcn_readfirstlane((int)it) + 4096u;
                    if (it >= 4096u + 256u) break;
#ifndef NO_NA
                    na_item<false>(p, shm, tidn >> 6, j, it, lane);
#endif
                }
            } else {
                const int tidd = get_tid(wave_s);
                const float lam = ((const float*)(p.ws + OFF_LAM))[j];
                const float lam_init = 0.8f - 0.6f * expf(-0.3f * (float)l);
                const int nitems = 1024 + (l < 3 ? 64 : 0);
                for (int v = blk; v < nitems; v += G) {
                    int bh, qrow0, nkt;
                    if (v < 1024) { const int rd = v >> 8, w = v & 255; bh = rd * 8 + (w & 7); const int qb = w >> 3; qrow0 = (bh >> 3) * TPB + 256 + qb * 128; nkt = 68; }
                    else { const int c = v - 1024; bh = c >> 1; qrow0 = (bh >> 3) * TPB + (c & 1) * 128; nkt = 4; }
#ifndef NO_DIFF
                    diff_item(p, shm, l, bh, qrow0, nkt, lam, lam_init, tidd);
#ifdef X_DIFF_TWICE
                    diff_item(p, shm, l, bh, qrow0, nkt, lam, lam_init, tidd);
#endif
#endif
                }
            }
        }
        GRID_BARRIER();
#ifdef X_EXTRA_SYNC
        GRID_BARRIER();
#endif
    }
    {
        asm volatile("" : "+s"(wave_s)); const int tid = get_tid(wave_s);
        const int wv = tid >> 6, lane = tid & 63;
        const float* rs = (const float*)(p.ws + OFF_RSQ16) + (size_t)8 * NROWS * 16;
        for (int row = blk * 8 + wv; row < 16384; row += G * 8) {
            const int b = row >> 12, t = row & 4095;
            const f32x4* q4 = (const f32x4*)(rs + (size_t)(b * TPB + 256 + t) * 16);
            const f32x4 tq = (q4[0] + q4[1]) + (q4[2] + q4[3]);
            const float rstd = rsqrtf(((tq[0] + tq[1]) + (tq[2] + tq[3])) * (1.0f / 1024.0f) + 1e-6f);
            float* o = p.out + (size_t)row * 1024;
#pragma unroll
            for (int jj = 0; jj < 4; ++jj) { const int n = 4 * lane + 256 * jj; f32x4 v = *(const f32x4*)(o + n); v = v * rstd * *(const f32x4*)(p.in[20] + n); *(f32x4*)(o + n) = v; }
        }
    }
}

extern "C" void kernel_launch(void* const* d_in, const int* in_sizes, int n_in, void* d_out, int out_size, void* d_ws, size_t ws_size, hipStream_t stream) {
    static int grid_blocks = 0;
    if (grid_blocks == 0) {
        if (n_in != 21 || ws_size < WS_END) { fprintf(stderr, "kernel_launch: need 21 inputs and >= %zu bytes of workspace; got %d, %zu\n", (size_t)WS_END, n_in, ws_size); grid_blocks = -1; return; }
        int dev = 0, cus = 0, per_cu = 0;
        hipGetDevice(&dev);
        hipDeviceGetAttribute(&cus, hipDeviceAttributeMultiprocessorCount, dev);
        if (hipFuncSetAttribute((const void*)mega, hipFuncAttributeMaxDynamicSharedMemorySize, LDS_BYTES) != hipSuccess) { fprintf(stderr, "kernel_launch: hipFuncSetAttribute failed\n"); }
        if (hipOccupancyMaxActiveBlocksPerMultiprocessor(&per_cu, (const void*)mega, 512, LDS_BYTES) != hipSuccess || per_cu < 1) { fprintf(stderr, "kernel_launch: occupancy query says %d\n", per_cu); per_cu = 1; }
        (void)hipGetLastError();
        grid_blocks = cus * 1;
        fprintf(stderr, "kernel_launch: cus %d per_cu %d grid %d ws %zu need %zu\n", cus, per_cu, grid_blocks, ws_size, (size_t)WS_END);
    }
    if (grid_blocks < 0) return;
    hipMemsetAsync(d_ws, 0, CTL_BYTES, stream);
    P p{};
    for (int i = 0; i < 21; ++i) p.in[i] = (const float*)d_in[i];
    p.out = (float*)d_out; p.ws = (unsigned char*)d_ws;
    void* args[] = {&p};
    hipError_t e = hipLaunchCooperativeKernel((const void*)mega, dim3(grid_blocks), dim3(512), args, LDS_BYTES, stream);
    if (e != hipSuccess) fprintf(stderr, "cooperative launch failed: %s (grid %d)\n", hipGetErrorString(e), grid_blocks);
}
```

```cpp
#include <hip/hip_runtime.h>
#include <hip/hip_cooperative_groups.h>
#include <cstdio>
namespace cg = cooperative_groups;

#define DI __device__ __forceinline__
#define LAS __attribute__((address_space(3)))
#define GAS __attribute__((address_space(1)))
typedef unsigned short bf16_t;
typedef short bf16x8 __attribute__((ext_vector_type(8)));
typedef float f32x2 __attribute__((ext_vector_type(2)));
typedef float f32x4 __attribute__((ext_vector_type(4)));
typedef float f32x16 __attribute__((ext_vector_type(16)));
typedef unsigned u32x2 __attribute__((ext_vector_type(2)));
typedef unsigned u32x4 __attribute__((ext_vector_type(4)));
typedef __bf16 bf2_t __attribute__((ext_vector_type(2)));

constexpr int NROWS = 17408, TPB = 4352;
constexpr float LOG2E = 1.4426950408889634f;
constexpr float QSCALE = 0.125f * LOG2E;

constexpr size_t al256(size_t x) { return (x + 255) & ~(size_t)255; }
constexpr size_t OFF_CTL = 0;
constexpr size_t OFF_ROWSQ = 256;
constexpr size_t OFF_BAR = al256(256 + 9 * (size_t)NROWS * 4);
constexpr size_t CTL_BYTES = al256(OFF_BAR + 3456 * 4);
constexpr size_t OFF_MOD = CTL_BYTES;
constexpr size_t OFF_SWMIX = OFF_MOD + 4 * 5 * 6144 * 4;
constexpr size_t OFF_SWMLP = OFF_SWMIX + 4 * 5 * 3072 * 4;
constexpr size_t OFF_LAM = OFF_SWMLP + 4 * 5 * 4096 * 4;
constexpr size_t OFF_ROPE = OFF_LAM + 256;
constexpr size_t OFF_XC = OFF_ROPE + 8192;
constexpr size_t OFF_XB = OFF_XC + 1024 * 1024 * 4;
constexpr size_t OFF_WINAB = OFF_XB + (size_t)NROWS * 1024 * 2;
constexpr size_t OFF_WOUTAB = OFF_WINAB + 2 * 2560 * 1024 * 2;
constexpr size_t OFF_WQKV = OFF_WOUTAB + 2 * 1024 * 1024 * 2;
constexpr size_t OFF_WOUTD = OFF_WQKV + 2 * 3072 * 1024 * 2;
constexpr size_t OFF_WMI = OFF_WOUTD + 2 * 1024 * 1024 * 2;
constexpr size_t OFF_WMO = OFF_WMI + 4ull * 4096 * 1024 * 2;
constexpr size_t OFF_TP = OFF_WMO + 4ull * 4096 * 1024 * 2;
constexpr size_t OFF_D128 = OFF_TP + 65536ull * 256 * 2;
constexpr size_t OFF_DFTC = OFF_D128 + 256 * 256 * 2;
constexpr size_t OFF_U = OFF_DFTC + 256 * 512 * 2;
constexpr size_t OFF_QK = OFF_U;
constexpr size_t OFF_FTL = OFF_QK + (size_t)NROWS * 1024 * 2;
constexpr size_t OFF_FTC = OFF_FTL + 2048ull * 8192 * 2;
constexpr size_t OFF_VT = OFF_QK + (size_t)NROWS * 2048 * 2;
constexpr size_t OFF_CAT = OFF_VT + (size_t)NROWS * 1024 * 2;
constexpr size_t OFF_R16 = OFF_U + (size_t)NROWS * 4096 * 2;
constexpr size_t OFF_RSQ16 = OFF_R16 + (size_t)NROWS * 1024 * 2;
constexpr size_t WS_END = OFF_RSQ16 + 9ull * NROWS * 16 * 4;
static_assert(OFF_CAT + (size_t)NROWS * 1024 * 2 == OFF_R16, "overlay");
static_assert(OFF_FTC + 2048ull * 512 * 2 == OFF_VT, "overlay2");
constexpr int LDS_BYTES = 131072 + 256;

struct P {
    const float* in[21];
    float* out;
    unsigned char* ws;
};

template <class T> DI T* as_global(T* p) { return (T*)(GAS T*)p; }
DI unsigned pk2(float a, float b) { bf2_t r = __builtin_convertvector((f32x2){a, b}, bf2_t); return __builtin_bit_cast(unsigned, r); }
DI bf16_t bf1(float a) { return (bf16_t)(pk2(a, 0.f) & 0xffffu); }
DI float wave_sum(float v) {
#pragma unroll
    for (int o = 1; o < 64; o <<= 1) v += __shfl_xor(v, o);
    return v;
}
DI int get_tid(int wave_s) { int lane; asm volatile("v_mbcnt_lo_u32_b32 %0, -1, 0\n\tv_mbcnt_hi_u32_b32 %0, -1, %0" : "=v"(lane)); return wave_s * 64 + lane; }
#define MFMA32(a, b, c) __builtin_amdgcn_mfma_f32_32x32x16_bf16((a), (b), (c), 0, 0, 0)

#define XB_TMO      128
#define XB_XCNT(j)  (256  + 64 * (j))
#define XB_XSUB(j)  (1280 + 64 * (j))
#define XB_XGEN(j)  (2304 + 64 * (j))
#define XB_TOP      3328
#define XB_TOPGEN   3392
#define XB_SPIN_CAP (1u << 20)
DI unsigned xb_ld(unsigned* p)              { return __hip_atomic_load(p, __ATOMIC_RELAXED, __HIP_MEMORY_SCOPE_AGENT); }
DI unsigned xb_add(unsigned* p, unsigned v) { return __hip_atomic_fetch_add(p, v, __ATOMIC_RELAXED, __HIP_MEMORY_SCOPE_AGENT); }
DI unsigned xb_xcc_id() { return (unsigned)__builtin_amdgcn_s_getreg((3 << 11) | 20) & 0xFu; }
#define XB_SPIN(cond, bar) do { unsigned _sp = 0; while (cond) { __builtin_amdgcn_s_sleep(1); \
    if ((++_sp & 255u) == 0u) { if (xb_ld(&(bar)[XB_TMO])) break; if (_sp > XB_SPIN_CAP) { atomicAdd(&(bar)[XB_TMO], 1u); break; } } } } while (0)
struct XcdBarrier { unsigned* bar; unsigned x; volatile LAS unsigned* st; };
DI XcdBarrier xcd_barrier_post(unsigned* bar, volatile LAS unsigned* st) {
    XcdBarrier b; b.bar = bar; b.x = xb_xcc_id(); b.st = st;
    if (threadIdx.x == 0) (void)xb_add(&bar[XB_XCNT(b.x)], 1u);
    return b;
}
DI void xcd_barrier_complete(unsigned* bar, unsigned x, unsigned& nloc, unsigned& nx) {
    const unsigned G = gridDim.x * gridDim.y * gridDim.z;
    unsigned sum, cnt, mine, sp = 0u;
    for (;;) {
        sum = 0u; cnt = 0u; mine = 0u;
#pragma unroll
        for (unsigned j = 0; j < 16; ++j) { const unsigned c = xb_ld(&bar[XB_XCNT(j)]); sum += c; cnt += (c > 0u) ? 1u : 0u; mine = (j == x) ? c : mine; }
        if (sum == G) break;
        __builtin_amdgcn_s_sleep(1);
        if ((++sp & 255u) == 0u) { if (xb_ld(&bar[XB_TMO])) break; if (sp > XB_SPIN_CAP) { atomicAdd(&bar[XB_TMO], 1u); break; } }
    }
    nloc = mine > 0u ? mine : 1u; nx = cnt > 0u ? cnt : 1u;
}
DI void xcd_barrier(const XcdBarrier& b, const int tid) {
    asm volatile("s_waitcnt vmcnt(0)" ::: "memory");
    __syncthreads();
    if (tid == 0) {
        unsigned* bar = b.bar;
        __builtin_amdgcn_s_waitcnt(0);
        unsigned nloc = b.st[0], nx = b.st[1];
        if (nloc == 0u) { xcd_barrier_complete(bar, b.x, nloc, nx); b.st[0] = nloc; b.st[1] = nx; }
        const unsigned old = xb_add(&bar[XB_XSUB(b.x)], 1u);
        const unsigned gen = old / nloc;
        if (old + 1u == (gen + 1u) * nloc) {
            __builtin_amdgcn_fence(__ATOMIC_RELEASE, "agent");
            asm volatile("s_waitcnt vmcnt(0)" ::: "memory");
            const unsigned og = xb_add(&bar[XB_TOP], 1u);
            const unsigned tg = og / nx;
            if (og + 1u == (tg + 1u) * nx) xb_add(&bar[XB_TOPGEN], 1u);
            else XB_SPIN(xb_ld(&bar[XB_TOPGEN]) == tg, bar);
            __builtin_amdgcn_fence(__ATOMIC_ACQUIRE, "agent");
            xb_add(&bar[XB_XGEN(b.x)], 1u);
            asm volatile("s_waitcnt vmcnt(0)" ::: "memory");
        } else {
            XB_SPIN(xb_ld(&bar[XB_XGEN(b.x)]) == gen, bar);
            __builtin_amdgcn_fence(__ATOMIC_ACQUIRE, "agent");
            asm volatile("s_waitcnt vmcnt(0)" ::: "memory");
        }
    }
    __syncthreads();
}

namespace pg8 {
constexpr int BM = 256, BK = 64, HALF = 128, HTB = HALF * BK * 2, STAGE_BYTES = 8 * HTB, NXCD = 8, WGM = 8;
DI int lds_byte(int r, int c) { const int st = (r >> 4) * 2 + (c >> 5), rr = r & 15, cc = c & 31, ob = rr * 64 + cc * 2; return st * 1024 + (ob ^ (((ob >> 9) & 1) << 5)); }
DI void stage_rc(int b, int& R, int& C) { const int st = b / 1024, sb = b % 1024, swz = sb ^ (((sb >> 9) & 1) << 5); R = (st >> 1) * 16 + swz / 64; C = (st & 1) * 32 + (swz % 64) / 2; }
DI int perm32(int rho) { const int n = rho >> 4, i = rho & 15; return 8 * (i >> 2) + 4 * n + (i & 3); }
struct Unit { int pm, pn; };
struct Gemm { const bf16_t* A; const bf16_t* Bt; int M, N, K; };
struct StaticOrder {
    int nM, nN, nwg, G, c, skip;
    DI void init(int M, int N, int G_, int c_, int skip_) { nM = M / BM; nN = N / BM; nwg = nM * nN; G = G_; c = c_; skip = skip_; }
    DI bool next(int i, Unit& u) const {
        const long L = (long)i * G + c; if (L >= nwg) return false;
        int wgid = (int)L; { const int q = nwg / NXCD, r = nwg % NXCD, xcd = wgid % NXCD, off = wgid / NXCD; wgid = (xcd < r ? xcd * (q + 1) : r * (q + 1) + (xcd - r) * q) + off; }
        const int nig = WGM * nN, gid = wgid / nig, fm = gid * WGM, gsz = (nM - fm) < WGM ? (nM - fm) : WGM;
        u.pm = fm + ((wgid % nig) % gsz); u.pn = (wgid % nig) / gsz; if (skip) u.pm += (u.pm >> 4) + 1; return true;
    }
};

template <class Epi>
DI void gemm_phase(LAS unsigned char* lds, const Gemm g, const StaticOrder& S, const Epi& E, const int tid) {
    const int wid = __builtin_amdgcn_readfirstlane(tid >> 6), lane = tid & 63, wr = wid >> 2, wc = wid & 3, fr = lane & 15, fq = lane >> 4;
    const int K = g.K, nt = K / BK;
    unsigned voffA[2], voffB[2];
#pragma unroll
    for (int i = 0; i < 2; ++i) { int R, C; stage_rc(tid * 16 + i * 8192, R, C); const int Rb = E.perm ? ((R & ~31) + perm32(R & 31)) : R;
        voffA[i] = (unsigned)(R * K + C) * 2u; voffB[i] = (unsigned)(Rb * K + C) * 2u; }
    const size_t kstep = (size_t)(BK * 2);
    const size_t hstep = (size_t)HALF * K * 2;
    const size_t tstep = 2 * hstep;
    const unsigned ldsw = (unsigned)wid * 1024u;
    const int aoff = lds_byte(wr * 64 + fr, fq * 8), boff = lds_byte(wc * 32 + fr, fq * 8);
#define PG8_SA(b, h) (((b) * 2 + (h)) * HTB)
#define PG8_SB(b, h) ((4 + (b) * 2 + (h)) * HTB)
#define PG8_STAGE(bufoff, gbase, voff) do { _Pragma("unroll") for (int _i = 0; _i < 2; ++_i) \
        __builtin_amdgcn_global_load_lds((const unsigned*)((const char*)(gbase) + (voff)[_i]), (LAS unsigned*)(lds + (bufoff) + ldsw + _i * 8192), 16, 0, 0); } while (0)
#define PG8_LDA(dst, b, h) do { _Pragma("unroll") for (int m = 0; m < 4; ++m) _Pragma("unroll") for (int k = 0; k < 2; ++k) dst[m][k] = *(const LAS bf16x8*)(lds + PG8_SA(b, h) + aoff + m * 2048 + k * 1024); } while (0)
#define PG8_LDB(dst, b, h) do { _Pragma("unroll") for (int n = 0; n < 2; ++n) _Pragma("unroll") for (int k = 0; k < 2; ++k) dst[n][k] = *(const LAS bf16x8*)(lds + PG8_SB(b, h) + boff + n * 2048 + k * 1024); } while (0)
#define PG8_MMA(ai, bj, At, Bt) do { __builtin_amdgcn_s_setprio(1); _Pragma("unroll") for (int m = 0; m < 4; ++m) _Pragma("unroll") for (int n = 0; n < 2; ++n) _Pragma("unroll") for (int k = 0; k < 2; ++k) \
        acc[ai][bj][m][n] = __builtin_amdgcn_mfma_f32_16x16x32_bf16(Bt[n][k], At[m][k], acc[ai][bj][m][n], 0, 0, 0); __builtin_amdgcn_s_setprio(0); } while (0)
#define PG8_WAIT_V(n) asm volatile("s_waitcnt vmcnt(" #n ")" ::: "memory")
#define PG8_WAIT_L(n) asm volatile("s_waitcnt lgkmcnt(" #n ")" ::: "memory")
#define PG8_BAR __builtin_amdgcn_s_barrier()
#define PG8_SCHED __builtin_amdgcn_sched_barrier(0)
    Unit cur, nxt; int ui = 0;
    if (!S.next(0, cur)) return;
    f32x4 acc[2][2][4][2];
#pragma unroll
    for (int a = 0; a < 2; ++a)
#pragma unroll
        for (int b = 0; b < 2; ++b)
#pragma unroll
            for (int m = 0; m < 4; ++m)
#pragma unroll
                for (int n = 0; n < 2; ++n) acc[a][b][m][n] = (f32x4){0.f, 0.f, 0.f, 0.f};
    bf16x8 At[4][2], B0[2][2], B1[2][2];
    const char* cA = (const char*)g.A + (size_t)cur.pm * tstep; const char* cB = (const char*)g.Bt + (size_t)cur.pn * tstep;
    PG8_STAGE(PG8_SB(0, 0), cB, voffB); PG8_STAGE(PG8_SA(0, 0), cA, voffA); PG8_STAGE(PG8_SB(0, 1), cB + hstep, voffB); PG8_STAGE(PG8_SA(0, 1), cA + hstep, voffA);
    if (wr == 1) PG8_BAR;
    PG8_WAIT_V(4); PG8_BAR;
    PG8_STAGE(PG8_SB(1, 0), cB + kstep, voffB); PG8_STAGE(PG8_SA(1, 0), cA + kstep, voffA); PG8_STAGE(PG8_SB(1, 1), cB + hstep + kstep, voffB);
    PG8_WAIT_V(6); PG8_BAR;
    for (;;) {
        const bool has_next = S.next(ui + 1, nxt);
        const char* nA = has_next ? (const char*)g.A + (size_t)nxt.pm * tstep : cA; const char* nB = has_next ? (const char*)g.Bt + (size_t)nxt.pn * tstep : cB;
        for (int t = 0; t < nt; t += 2) {
            const bool last = (t == nt - 2);
            const char* a1 = cA + (size_t)(t + 1) * kstep;
            const char* a2 = last ? nA : cA + (size_t)(t + 2) * kstep; const char* b2 = last ? nB : cB + (size_t)(t + 2) * kstep;
            const char* a3 = a2 + kstep; const char* b3 = b2 + kstep;
            PG8_LDB(B0, 0, 0); PG8_SCHED; PG8_LDA(At, 0, 0); PG8_STAGE(PG8_SA(1, 1), a1 + hstep, voffA);
            PG8_WAIT_L(8); PG8_BAR; PG8_WAIT_L(0); PG8_MMA(0, 0, At, B0); PG8_BAR; PG8_SCHED;
            PG8_LDB(B1, 0, 1); PG8_STAGE(PG8_SB(0, 0), b2, voffB);
            PG8_BAR; PG8_WAIT_L(0); PG8_MMA(0, 1, At, B1); PG8_BAR;
            PG8_LDA(At, 0, 1); PG8_STAGE(PG8_SA(0, 0), a2, voffA);
            PG8_BAR; PG8_WAIT_L(0); PG8_MMA(1, 0, At, B0); PG8_BAR; PG8_SCHED;
            PG8_STAGE(PG8_SB(0, 1), b2 + hstep, voffB);
            PG8_WAIT_V(6); PG8_BAR; PG8_MMA(1, 1, At, B1); PG8_BAR;
            PG8_LDB(B0, 1, 0); PG8_SCHED; PG8_LDA(At, 1, 0); PG8_STAGE(PG8_SA(0, 1), a2 + hstep, voffA);
            PG8_WAIT_L(8); PG8_BAR; PG8_WAIT_L(0); PG8_MMA(0, 0, At, B0); PG8_BAR; PG8_SCHED;
            PG8_LDB(B1, 1, 1); PG8_STAGE(PG8_SB(1, 0), b3, voffB);
            PG8_BAR; PG8_WAIT_L(0); PG8_MMA(0, 1, At, B1); PG8_BAR;
            PG8_LDA(At, 1, 1); PG8_STAGE(PG8_SA(1, 0), a3, voffA);
            PG8_BAR; PG8_WAIT_L(0); PG8_MMA(1, 0, At, B0); PG8_BAR; PG8_SCHED;
            PG8_STAGE(PG8_SB(1, 1), b3 + hstep, voffB);
            PG8_WAIT_V(6); PG8_BAR; PG8_MMA(1, 1, At, B1); PG8_BAR;
        }
        { int t2 = tid; asm volatile("" : "+v"(t2)); const int w2 = __builtin_amdgcn_readfirstlane(t2 >> 6), l2 = t2 & 63; E(acc, cur, w2 >> 2, w2 & 3, l2 & 15, l2 >> 4); }
        if (!has_next) break;
#pragma unroll
        for (int a = 0; a < 2; ++a)
#pragma unroll
            for (int b = 0; b < 2; ++b)
#pragma unroll
                for (int m = 0; m < 4; ++m)
#pragma unroll
                    for (int n = 0; n < 2; ++n) acc[a][b][m][n] = (f32x4){0.f, 0.f, 0.f, 0.f};
        cur = nxt; cA = nA; cB = nB; ++ui;
    }
    PG8_WAIT_V(0);
    if (wr == 0) PG8_BAR;
    PG8_BAR;
#undef PG8_SA
#undef PG8_SB
#undef PG8_STAGE
#undef PG8_LDA
#undef PG8_LDB
#undef PG8_MMA
#undef PG8_WAIT_V
#undef PG8_WAIT_L
#undef PG8_BAR
#undef PG8_SCHED
}
}

DI int perm_pos(int t) { return (t & ~12) | ((t & 4) << 1) | ((t & 8) >> 1); }
struct Epi {
    int mode;
    int perm, l, s;
    unsigned char* wsp; float* outp; const float* in0; const float* in2; const float* in6; const float* in7;
};
struct ColVec { f32x4 a0, a1, b0, b1; };
DI ColVec load_colvec(const Epi& E, unsigned char* ws, int l_, int bsel, int c0) {
    ColVec cv;
    if (E.mode <= 2) {
        const int nsw = (E.mode == 2) ? 4096 : 3072;
        const float* sw = (E.mode == 2) ? (const float*)(ws + OFF_SWMLP) + (size_t)l_ * 5 * 4096 : (const float*)(ws + OFF_SWMIX) + (size_t)l_ * 5 * 3072;
        const float* q = sw + (size_t)bsel * nsw + c0;
        cv.a0 = *(const f32x4*)q; cv.a1 = *(const f32x4*)(q + 4); cv.b0 = cv.a0; cv.b1 = cv.a1;
    } else {
        const float* MOD = (const float*)(ws + OFF_MOD);
        const bool first = (E.s == 2);
        const float* gate = MOD + (size_t)l_ * 5 * 6144 + (first ? 2 : 5) * 1024 + (size_t)bsel * 6144 + c0;
        cv.a0 = *(const f32x4*)gate; cv.a1 = *(const f32x4*)(gate + 4);
        const float* gnext = first ? E.in7 + l_ * 1024 : (l_ < 3 ? E.in6 + (l_ + 1) * 1024 : nullptr);
        if (gnext) { const float* sc = (first ? MOD + (size_t)l_ * 5 * 6144 + 4 * 1024 : MOD + (size_t)(l_ + 1) * 5 * 6144 + 1024) + (size_t)bsel * 6144 + c0;
            cv.b0 = *(const f32x4*)(gnext + c0) * (*(const f32x4*)sc + 1.0f); cv.b1 = *(const f32x4*)(gnext + c0 + 4) * (*(const f32x4*)(sc + 4) + 1.0f); }
        else { cv.b0 = (f32x4){0.f, 0.f, 0.f, 0.f}; cv.b1 = cv.b0; }
    }
    return cv;
}
DI float row_rstd(const Epi& E, unsigned char* ws, int l_, int row) {
    const f32x4* q = (const f32x4*)((const float*)(ws + OFF_RSQ16) + ((size_t)(2 * l_ + (E.mode == 2 ? 1 : 0)) * NROWS + row) * 16);
    const f32x4 a = q[0], b_ = q[1], c = q[2], d = q[3];
    const f32x4 t = (a + b_) + (c + d);
    return rsqrtf(((t[0] + t[1]) + (t[2] + t[3])) * (1.0f / 1024.0f) + 1e-6f);
}
DI float emit8(const Epi& E, unsigned char* ws, int l_, int row, int b, int tall, bool isctx, int c0, float (&v)[8], const ColVec& cv, float rstd) {
    if (E.mode <= 2) {
#pragma unroll
        for (int i = 0; i < 4; ++i) { v[i] = v[i] * rstd + cv.a0[i]; v[4 + i] = v[4 + i] * rstd + cv.a1[i]; }
        if (E.mode == 2) {
            bf16_t* ob = (bf16_t*)(ws + OFF_U);
#pragma unroll
            for (int i = 0; i < 8; ++i) { const float r = fmaxf(v[i], 0.f); v[i] = r * r; }
            u32x4 w; w.x = pk2(v[0], v[1]); w.y = pk2(v[2], v[3]); w.z = pk2(v[4], v[5]); w.w = pk2(v[6], v[7]);
            *(u32x4*)(ob + (size_t)row * 4096 + c0) = w;
        } else if (E.mode == 0) {
            if (c0 < 1024) {
                const int cs = c0 >> 9; const int gc0 = (c0 & 511);
                if (isctx) { bf16_t* d = (bf16_t*)(ws + OFF_FTC) + ((size_t)(b * 512 + gc0) * 2 + cs) * 256 + tall;
#pragma unroll
                    for (int i = 0; i < 8; ++i) d[(size_t)i * 512] = bf1(v[i]);
                } else { bf16_t* d = (bf16_t*)(ws + OFF_FTL) + ((size_t)(b * 512 + gc0) * 2 + cs) * 4096 + (tall - 256);
#pragma unroll
                    for (int i = 0; i < 8; ++i) d[(size_t)i * 8192] = bf1(v[i]); }
            } else if (c0 < 2048) {
                const float sc = (c0 < 1536) ? QSCALE : 1.0f;
                u32x4 w; w.x = pk2(v[0] * sc, v[1] * sc); w.y = pk2(v[2] * sc, v[3] * sc); w.z = pk2(v[4] * sc, v[5] * sc); w.w = pk2(v[6] * sc, v[7] * sc);
                *(u32x4*)((bf16_t*)(ws + OFF_QK) + (size_t)row * 1024 + (c0 - 1024)) = w;
            } else {
                const int cv_ = c0 - 2048; const int h = cv_ >> 6, d0 = cv_ & 63;
                bf16_t* d = (bf16_t*)(ws + OFF_VT) + ((size_t)((b * 8 + h) * 64 + d0)) * TPB + perm_pos(tall);
#pragma unroll
                for (int i = 0; i < 8; ++i) d[(size_t)i * TPB] = bf1(v[i]);
            }
        } else {
            if (c0 < 2048) {
                if (!isctx) {
                    const int t = tall - 256; const int pos = ((c0 >> 5) & 1) ? (t & 63) : (t >> 6);
                    const float* rp = (const float*)(ws + OFF_ROPE) + (size_t)(pos * 16 + (c0 & 8)) * 2;
                    const bool hi2 = ((c0 >> 4) & 1) != 0;
#pragma unroll
                    for (int i = 0; i < 8; ++i) { const float pv = __shfl_xor(v[i], 32); const float cs_ = rp[2 * i], sn = rp[2 * i + 1];
                        v[i] = hi2 ? (pv * sn + v[i] * cs_) : (v[i] * cs_ - pv * sn); }
                }
                const float sc = (c0 < 1024) ? QSCALE : 1.0f;
                u32x4 w; w.x = pk2(v[0] * sc, v[1] * sc); w.y = pk2(v[2] * sc, v[3] * sc); w.z = pk2(v[4] * sc, v[5] * sc); w.w = pk2(v[6] * sc, v[7] * sc);
                *(u32x4*)((bf16_t*)(ws + OFF_QK) + (size_t)row * 2048 + c0) = w;
            } else {
                const int cv_ = c0 - 2048; const int h = cv_ >> 7, d0 = cv_ & 127;
                bf16_t* d = (bf16_t*)(ws + OFF_VT) + ((size_t)((b * 8 + h) * 128 + d0)) * TPB + perm_pos(tall);
#pragma unroll
                for (int i = 0; i < 8; ++i) d[(size_t)i * TPB] = bf1(v[i]);
            }
        }
        return 0.f;
    } else {
        const bool l0 = (E.s == 2) && l_ == 0;
        const bool lastw = (E.s == 4) && l_ == 3;
        f32x4 r0, r1;
        if (l0) { const size_t rloc = isctx ? (size_t)(b * 256 + tall) : (size_t)(b * 4096 + tall - 256);
            const float* rp = (isctx ? E.in2 : E.in0) + rloc * 1024 + c0; r0 = *(const f32x4*)rp; r1 = *(const f32x4*)(rp + 4); }
        else { const u32x4 rw = *(const u32x4*)((const bf16_t*)(ws + OFF_R16) + (size_t)row * 1024 + c0);
            r0 = (f32x4){__uint_as_float(rw.x << 16), __uint_as_float(rw.x & 0xffff0000u), __uint_as_float(rw.y << 16), __uint_as_float(rw.y & 0xffff0000u)};
            r1 = (f32x4){__uint_as_float(rw.z << 16), __uint_as_float(rw.z & 0xffff0000u), __uint_as_float(rw.w << 16), __uint_as_float(rw.w & 0xffff0000u)}; }
        const f32x4 x0 = r0 + cv.a0 * (f32x4){v[0], v[1], v[2], v[3]};
        const f32x4 x1 = r1 + cv.a1 * (f32x4){v[4], v[5], v[6], v[7]};
        if (lastw) { float* op = E.outp + (size_t)(b * 4096 + tall - 256) * 1024 + c0; *(f32x4*)op = x0; *(f32x4*)(op + 4) = x1; }
        else { u32x4 w; w.x = pk2(x0[0], x0[1]); w.y = pk2(x0[2], x0[3]); w.z = pk2(x1[0], x1[1]); w.w = pk2(x1[2], x1[3]);
            *(u32x4*)((bf16_t*)(ws + OFF_R16) + (size_t)row * 1024 + c0) = w; }
        const bool has_next = (E.s == 2) || l_ < 3;
        if (has_next) { const f32x4 y0 = x0 * cv.b0, y1 = x1 * cv.b1; u32x4 w; w.x = pk2(y0[0], y0[1]); w.y = pk2(y0[2], y0[3]); w.z = pk2(y1[0], y1[1]); w.w = pk2(y1[2], y1[3]);
            *(u32x4*)((bf16_t*)(ws + OFF_XB) + (size_t)row * 1024 + c0) = w; }
        return ((x0[0] * x0[0] + x0[1] * x0[1]) + (x0[2] * x0[2] + x0[3] * x0[3])) + ((x1[0] * x1[0] + x1[1] * x1[1]) + (x1[2] * x1[2] + x1[3] * x1[3]));
    }
}
DI float* rowsq_out_ptr(const Epi& E, unsigned char* ws, int l_) { return (float*)(ws + OFF_RSQ16) + (size_t)(2 * l_ + (E.s == 2 ? 1 : 2)) * NROWS * 16; }

struct EpiPg8 {
    Epi E; int perm;
    DI void operator()(const f32x4 (&acc)[2][2][4][2], const pg8::Unit& u, int wr, int wc, int fr, int fq) const {
        unsigned z_ = 0u; int l_ = E.l; asm volatile("" : "+s"(z_), "+s"(l_)); unsigned char* ws = E.wsp + z_;
        if (E.mode <= 2) {
            const int b = u.pm / 17, tp = u.pm % 17; const bool isctx = (tp == 0); const int bsel = isctx ? 4 : b;
            const int colt = u.pn * 256 + wc * 32 + 8 * fq;
            ColVec cv[2];
#pragma unroll
            for (int bj = 0; bj < 2; ++bj) cv[bj] = load_colvec(E, ws, l_, bsel, colt + 128 * bj);
#pragma unroll
            for (int ai = 0; ai < 2; ++ai)
#pragma unroll
                for (int m = 0; m < 4; ++m) {
                    const int rl = ai * 128 + wr * 64 + m * 16 + fr; const int row = u.pm * 256 + rl; const int tall = tp * 256 + rl;
                    const float rstd = row_rstd(E, ws, l_, row);
#pragma unroll
                    for (int bj = 0; bj < 2; ++bj) {
                        float v[8];
#pragma unroll
                        for (int i = 0; i < 4; ++i) { v[i] = acc[ai][bj][m][0][i]; v[4 + i] = acc[ai][bj][m][1][i]; }
                        (void)emit8(E, ws, l_, row, b, tall, isctx, colt + 128 * bj, v, cv[bj], rstd);
                    }
                }
        } else if (E.mode == 3) {
            const int b = u.pm / 17, tp = u.pm % 17; const bool isctx = (tp == 0); const int bsel = isctx ? 4 : b;
            const int colt = u.pn * 256 + wc * 32 + 8 * fq;
            ColVec cv[2];
#pragma unroll
            for (int bj = 0; bj < 2; ++bj) cv[bj] = load_colvec(E, ws, l_, bsel, colt + 128 * bj);
            float* rso = rowsq_out_ptr(E, ws, l_);
#pragma unroll
            for (int ai = 0; ai < 2; ++ai)
#pragma unroll
                for (int m = 0; m < 4; ++m) {
                    const int rl = ai * 128 + wr * 64 + m * 16 + fr; const int row = u.pm * 256 + rl; const int tall = tp * 256 + rl;
                    float ss = 0.f;
#pragma unroll
                    for (int bj = 0; bj < 2; ++bj) {
                        float v[8];
#pragma unroll
                        for (int i = 0; i < 4; ++i) { v[i] = acc[ai][bj][m][0][i]; v[4 + i] = acc[ai][bj][m][1][i]; }
                        ss += emit8(E, ws, l_, row, b, tall, isctx, colt + 128 * bj, v, cv[bj], 0.f);
                    }
                    ss += __shfl_xor(ss, 16); ss += __shfl_xor(ss, 32);
                    if (fq == 0) rso[(size_t)row * 16 + u.pn * 4 + wc] = ss;
                }
        } else if (E.mode == 4) {
            bf16_t* ob = (bf16_t*)(ws + OFF_CAT);
            const float alpha = 0.0013810679320049757f;
#pragma unroll
            for (int ai = 0; ai < 2; ++ai)
#pragma unroll
                for (int m = 0; m < 4; ++m) {
                    const int R = u.pm * 256 + ai * 128 + wr * 64 + m * 16 + fr;
                    const int b = R >> 14, k1 = (R >> 9) & 31, gc = R & 511;
                    const int k2 = wc * 32 + 8 * fq;
                    bf16_t* d = ob + (size_t)(b * TPB + 256 + k1 + 32 * k2) * 1024 + gc;
#pragma unroll
                    for (int i = 0; i < 4; ++i) { d[(size_t)i * 32 * 1024] = bf1(acc[ai][0][m][0][i] * alpha); d[(size_t)(4 + i) * 32 * 1024] = bf1(acc[ai][0][m][1][i] * alpha); }
                }
        } else {
            bf16_t* ob = (bf16_t*)(ws + OFF_CAT);
            const float alpha = 0.005524271728019903f;
            const int nrow0 = u.pn * 256 + wc * 32 + 8 * fq;
#pragma unroll
            for (int ai = 0; ai < 2; ++ai)
#pragma unroll
                for (int m = 0; m < 4; ++m) {
                    const int k = u.pm * 256 + ai * 128 + wr * 64 + m * 16 + fr;
#pragma unroll
                    for (int bj = 0; bj < 2; ++bj) { const int nr = nrow0 + 128 * bj; const int b = nr >> 9, gc = nr & 511;
                        const f32x4 a0 = acc[ai][bj][m][0] * alpha, a1 = acc[ai][bj][m][1] * alpha;
                        u32x4 w; w.x = pk2(a0[0], a0[1]); w.y = pk2(a0[2], a0[3]); w.z = pk2(a1[0], a1[1]); w.w = pk2(a1[2], a1[3]);
                        *(u32x4*)(ob + (size_t)(b * TPB + k) * 1024 + gc) = w; }
                }
        }
    }
};

constexpr int bitrev5(int x) { return ((x & 1) << 4) | ((x & 2) << 2) | (x & 4) | ((x & 8) >> 2) | ((x & 16) >> 4); }
DI float bf2f(bf16_t v) { return __uint_as_float(((unsigned)v) << 16); }
DI void fft_stage1_item(unsigned char* ws, int item, int tid) {
    constexpr float FC[16] = {1.0f, 0.98078528040323043f, 0.92387953251128674f, 0.83146961230254524f, 0.70710678118654752f, 0.55557023301960218f, 0.38268343236508977f, 0.19509032201612825f,
                              0.0f, -0.19509032201612825f, -0.38268343236508977f, -0.55557023301960218f, -0.70710678118654752f, -0.83146961230254524f, -0.92387953251128674f, -0.98078528040323043f};
    constexpr float FS[16] = {0.0f, 0.19509032201612825f, 0.38268343236508977f, 0.55557023301960218f, 0.70710678118654752f, 0.83146961230254524f, 0.92387953251128674f, 0.98078528040323043f,
                              1.0f, 0.98078528040323043f, 0.92387953251128674f, 0.83146961230254524f, 0.70710678118654752f, 0.55557023301960218f, 0.38268343236508977f, 0.19509032201612825f};
    const int nrow = item * 4 + (tid >> 7), n2 = tid & 127;
    const bf16_t* src = (const bf16_t*)(ws + OFF_FTL) + (size_t)nrow * 8192 + n2;
    float ar[32], ai[32];
#pragma unroll
    for (int n1 = 0; n1 < 32; ++n1) { ar[bitrev5(n1)] = bf2f(__builtin_nontemporal_load(src + 128 * n1)); ai[bitrev5(n1)] = -bf2f(__builtin_nontemporal_load(src + 4096 + 128 * n1)); }
#pragma unroll
    for (int st = 1; st <= 5; ++st) {
        const int m = 1 << st, h = m >> 1;
#pragma unroll
        for (int k = 0; k < 32; k += m)
#pragma unroll
            for (int jj = 0; jj < h; ++jj) {
                const int idx = jj * (32 / m);
                const float wr_ = FC[idx], wi_ = -FS[idx];
                const float xr = ar[k + jj + h], xi = ai[k + jj + h];
                const float tr = wr_ * xr - wi_ * xi, ti = wr_ * xi + wi_ * xr;
                const float ur = ar[k + jj], ui = ai[k + jj];
                ar[k + jj] = ur + tr; ai[k + jj] = ui + ti; ar[k + jj + h] = ur - tr; ai[k + jj + h] = ui - ti;
            }
    }
    const int b = nrow >> 9, gc = nrow & 511;
    bf16_t* dst = (bf16_t*)(ws + OFF_TP) + ((size_t)(b * 32) * 512 + gc) * 256 + n2;
#pragma unroll
    for (int k1 = 0; k1 < 32; ++k1) {
        const float rev = (float)(n2 * k1) * (1.0f / 4096.0f);
        const float c = __builtin_amdgcn_cosf(rev), sn = __builtin_amdgcn_sinf(rev);
        const float re = ar[k1] * c + ai[k1] * sn, im = ai[k1] * c - ar[k1] * sn;
        dst[(size_t)k1 * 512 * 256] = bf1(re); dst[(size_t)k1 * 512 * 256 + 128] = bf1(im);
    }
}

DI int mini_perm(int p) { const int q = p & 255, xcd = q & 7, idx = q >> 3; return (p & ~255) + ((((idx >> 4) + 2 * xcd) & 15) << 4) + (idx & 15); }
DI void mini_gemm_tile(const Epi& E, const bf16_t* A, const bf16_t* Bt, int K, int mt_lin, unsigned char* shm, int tid) {
    const int mt = mini_perm(mt_lin);
    const int rt = mt & 15, ct = mt >> 4;
    const int wv = tid >> 6, lane = tid & 63, l31 = lane & 31, hi = lane >> 5;
    const int ksl = K >> 3, kbeg = wv * ksl;
    const bf16_t* ap[2]; const bf16_t* bp[2];
#pragma unroll
    for (int mi = 0; mi < 2; ++mi) { const int r = rt * 64 + 32 * mi + l31; const int grow = (r >> 8) * TPB + (r & 255); ap[mi] = A + (size_t)grow * K + kbeg + 8 * hi; }
#pragma unroll
    for (int ni = 0; ni < 2; ++ni) bp[ni] = Bt + (size_t)(ct * 64 + 32 * ni + l31) * K + kbeg + 8 * hi;
    f32x16 acc[2][2];
#pragma unroll
    for (int mi = 0; mi < 2; ++mi)
#pragma unroll
        for (int ni = 0; ni < 2; ++ni)
#pragma unroll
            for (int i = 0; i < 16; ++i) acc[mi][ni][i] = 0.f;
    for (int k0 = 0; k0 < ksl; k0 += 128) {
        bf16x8 fa[8][2], fb[8][2];
#pragma unroll
        for (int q = 0; q < 8; ++q) { fa[q][0] = *(const bf16x8*)(ap[0] + k0 + 16 * q); fa[q][1] = *(const bf16x8*)(ap[1] + k0 + 16 * q); fb[q][0] = *(const bf16x8*)(bp[0] + k0 + 16 * q); fb[q][1] = *(const bf16x8*)(bp[1] + k0 + 16 * q); }
#pragma unroll
        for (int q = 0; q < 8; ++q) { acc[0][0] = MFMA32(fa[q][0], fb[q][0], acc[0][0]); acc[0][1] = MFMA32(fa[q][0], fb[q][1], acc[0][1]); acc[1][0] = MFMA32(fa[q][1], fb[q][0], acc[1][0]); acc[1][1] = MFMA32(fa[q][1], fb[q][1], acc[1][1]); }
    }
    float* red = (float*)shm + wv * 4096;
#pragma unroll
    for (int mi = 0; mi < 2; ++mi)
#pragma unroll
        for (int ni = 0; ni < 2; ++ni)
#pragma unroll
            for (int i = 0; i < 16; ++i) red[(32 * mi + (i & 3) + 8 * (i >> 2) + 4 * hi) * 64 + 32 * ni + l31] = acc[mi][ni][i];
    __syncthreads();
    {
        const int r = tid >> 3, cg = tid & 7;
        const float* src = (const float*)shm + r * 64 + cg * 8;
        f32x4 s0 = *(const f32x4*)src, s1 = *(const f32x4*)(src + 4);
#pragma unroll
        for (int w = 1; w < 8; ++w) { s0 += *(const f32x4*)(src + w * 4096); s1 += *(const f32x4*)(src + w * 4096 + 4); }
        float v[8] = {s0[0], s0[1], s0[2], s0[3], s1[0], s1[1], s1[2], s1[3]};
        const int cr = rt * 64 + r; const int b = cr >> 8, tall = cr & 255; const int row = b * TPB + tall; const int c0 = ct * 64 + cg * 8;
        const ColVec cv = load_colvec(E, E.wsp, E.l, 4, c0);
        const float rstd = (E.mode <= 2) ? row_rstd(E, E.wsp, E.l, row) : 0.f;
        float ss = emit8(E, E.wsp, E.l, row, b, tall, true, c0, v, cv, rstd);
        if (E.mode == 3) { ss += __shfl_xor(ss, 1); ss += __shfl_xor(ss, 2); ss += __shfl_xor(ss, 4);
            if (cg == 0) rowsq_out_ptr(E, E.wsp, E.l)[(size_t)row * 16 + ct] = ss; }
    }
    __syncthreads();
}

DI void mini_gemm_seq1024(const Epi& E, const bf16_t* A, const bf16_t* Bt, int mt0, int nmt, int G, unsigned char* shm, int tid) {
    if (mt0 >= nmt) return;
    constexpr int K = 1024;
    const int wv = tid >> 6, lane = tid & 63, l31 = lane & 31, hi = lane >> 5;
    const int kbeg = wv * 128;
    bf16x8 fa[8][2], fb[8][2];
#define MINI_LOAD(mt_) do { const int pm_ = mini_perm(mt_); const int rt_ = pm_ & 15, ct_ = pm_ >> 4; \
        _Pragma("unroll") for (int mi = 0; mi < 2; ++mi) { const int r_ = rt_ * 64 + 32 * mi + l31; const bf16_t* ap_ = A + (size_t)((r_ >> 8) * TPB + (r_ & 255)) * K + kbeg + 8 * hi; \
            _Pragma("unroll") for (int q = 0; q < 8; ++q) fa[q][mi] = *(const bf16x8*)(ap_ + 16 * q); } \
        _Pragma("unroll") for (int ni = 0; ni < 2; ++ni) { const bf16_t* bp_ = Bt + (size_t)(ct_ * 64 + 32 * ni + l31) * K + kbeg + 8 * hi; \
            _Pragma("unroll") for (int q = 0; q < 8; ++q) fb[q][ni] = *(const bf16x8*)(bp_ + 16 * q); } } while (0)
    MINI_LOAD(mt0);
    for (int mt = mt0; mt < nmt; mt += G) {
        const int pmt = mini_perm(mt); const int rt = pmt & 15, ct = pmt >> 4;
        f32x16 acc[2][2];
#pragma unroll
        for (int mi = 0; mi < 2; ++mi)
#pragma unroll
            for (int ni = 0; ni < 2; ++ni)
#pragma unroll
                for (int i = 0; i < 16; ++i) acc[mi][ni][i] = 0.f;
#pragma unroll
        for (int q = 0; q < 8; ++q) { acc[0][0] = MFMA32(fa[q][0], fb[q][0], acc[0][0]); acc[0][1] = MFMA32(fa[q][0], fb[q][1], acc[0][1]); acc[1][0] = MFMA32(fa[q][1], fb[q][0], acc[1][0]); acc[1][1] = MFMA32(fa[q][1], fb[q][1], acc[1][1]); }
        float* red = (float*)shm + wv * 4096;
#pragma unroll
        for (int mi = 0; mi < 2; ++mi)
#pragma unroll
            for (int ni = 0; ni < 2; ++ni)
#pragma unroll
                for (int i = 0; i < 16; ++i) red[(32 * mi + (i & 3) + 8 * (i >> 2) + 4 * hi) * 64 + 32 * ni + l31] = acc[mi][ni][i];
        if (mt + G < nmt) MINI_LOAD(mt + G);
        __syncthreads();
        {
            const int r = tid >> 3, cg = tid & 7;
            const float* src = (const float*)shm + r * 64 + cg * 8;
            f32x4 s0 = *(const f32x4*)src, s1 = *(const f32x4*)(src + 4);
#pragma unroll
            for (int w = 1; w < 8; ++w) { s0 += *(const f32x4*)(src + w * 4096); s1 += *(const f32x4*)(src + w * 4096 + 4); }
            float v[8] = {s0[0], s0[1], s0[2], s0[3], s1[0], s1[1], s1[2], s1[3]};
            const int cr = rt * 64 + r; const int b = cr >> 8, tall = cr & 255; const int row = b * TPB + tall; const int c0 = ct * 64 + cg * 8;
            const ColVec cv = load_colvec(E, E.wsp, E.l, 4, c0);
            const float rstd = (E.mode <= 2) ? row_rstd(E, E.wsp, E.l, row) : 0.f;
            float ss = emit8(E, E.wsp, E.l, row, b, tall, true, c0, v, cv, rstd);
            if (E.mode == 3) { ss += __shfl_xor(ss, 1); ss += __shfl_xor(ss, 2); ss += __shfl_xor(ss, 4);
                if (cg == 0) rowsq_out_ptr(E, E.wsp, E.l)[(size_t)row * 16 + ct] = ss; }
        }
        __syncthreads();
    }
#undef MINI_LOAD
}

DI bf16x8 pack8(const f32x16& x, int s) {
    u32x4 p; p.x = pk2(x[8 * s], x[8 * s + 1]); p.y = pk2(x[8 * s + 2], x[8 * s + 3]); p.z = pk2(x[8 * s + 4], x[8 * s + 5]); p.w = pk2(x[8 * s + 6], x[8 * s + 7]);
    return __builtin_bit_cast(bf16x8, p);
}
DI bool softmax_tile(f32x16& s0, f32x16& s1, f32x16& negm, float& mref, float& l, const bool first, float& alpha) {
    float mx = fmaxf(s0[0], s1[0]);
#pragma unroll
    for (int i = 1; i < 16; ++i) mx = fmaxf(fmaxf(mx, s0[i]), s1[i]);
    mx = fmaxf(mx, __shfl_xor(mx, 32));
    const bool resc = first || (__builtin_amdgcn_ballot_w64(mx > 8.0f) != 0ull);
    alpha = 1.0f;
    if (resc) {
        const float delta = first ? mx : fmaxf(mx, 0.f);
        mref += delta;
        const float nm = -mref;
#pragma unroll
        for (int i = 0; i < 16; ++i) { negm[i] = nm; s0[i] -= delta; s1[i] -= delta; }
        alpha = __builtin_amdgcn_exp2f(-delta);
        l *= alpha;
    }
    float sum = 0.f;
#pragma unroll
    for (int i = 0; i < 16; ++i) { s0[i] = __builtin_amdgcn_exp2f(s0[i]); sum += s0[i]; }
#pragma unroll
    for (int i = 0; i < 16; ++i) { s1[i] = __builtin_amdgcn_exp2f(s1[i]); sum += s1[i]; }
    l += sum;
    return resc;
}

template <bool ALLOW_NA> DI void na_item(const P& p, unsigned char* shm, int wv, int j, unsigned item, int lane) {
    const bf16_t* QK = (const bf16_t*)(p.ws + OFF_QK);
    const bf16_t* VT = (const bf16_t*)(p.ws + OFF_VT);
    bf16_t* CAT = (bf16_t*)(p.ws + OFF_CAT);
    const int l31 = lane & 31, hi = lane >> 5;
    int b, h, qrow, ntiles, r = 0, qc = 0; bool na;
    if (ALLOW_NA && item < 4096u) { na = true; const int half = item & 1; h = (item >> 1) & 7; r = (item >> 4) & 63; b = item >> 10; qc = half * 32 + l31; qrow = b * TPB + 256 + r * 64 + qc; ntiles = 12; }
    else { const int it = item - 4096; na = false; const int qb = it & 7; h = (it >> 3) & 7; b = it >> 6; qrow = b * TPB + qb * 32 + l31; ntiles = 4; }
    bf16x8 qf[4];
#pragma unroll
    for (int c = 0; c < 4; ++c) qf[c] = *(const bf16x8*)(QK + (size_t)qrow * 1024 + h * 64 + 16 * c + 8 * hi);
    const int rs = min(max(r - 4, 0), 56), cs = min(max(qc - 8, 0), 48);
    const bf16_t* vbase = VT + (size_t)((b * 8 + h) * 64) * TPB;
    const float* rpb = p.in[12] + (size_t)(j * 8 + h) * 15 * 31;
    float* tab = (float*)(shm + (size_t)wv * 8192);
    if (na) {
        for (int idx = lane; idx < 465; idx += 64) tab[(idx / 31) * 128 + 48 + idx % 31] = rpb[idx] * LOG2E;
        __builtin_amdgcn_wave_barrier();
    }
    f32x16 o[2]; float m = 0.f, l = 0.f;
#pragma unroll
    for (int d = 0; d < 2; ++d)
#pragma unroll
        for (int i = 0; i < 16; ++i) o[d][i] = 0.f;
#define NA_POS0(tt_) ((na && (tt_) < 8) ? 256 + (rs + (tt_)) * 64 : (na ? ((tt_) - 8) * 64 : (tt_) * 64))
#define NA_LOADK(KF, tt_) do { const int p0_ = NA_POS0(tt_); const bf16_t* kp_ = QK + (size_t)(b * TPB + p0_ + l31) * 1024 + 512 + h * 64 + 8 * hi; \
        _Pragma("unroll") for (int kb = 0; kb < 2; ++kb) _Pragma("unroll") for (int c = 0; c < 4; ++c) KF[kb][c] = *(const bf16x8*)(kp_ + (size_t)kb * 32 * 1024 + 16 * c); } while (0)
#define NA_LOADV(VF, tt_) do { const int p0_ = NA_POS0(tt_); const bf16_t* vp_ = vbase + (size_t)l31 * TPB + p0_ + 8 * hi; \
        _Pragma("unroll") for (int d = 0; d < 2; ++d) _Pragma("unroll") for (int q4 = 0; q4 < 4; ++q4) VF[d][q4] = *(const bf16x8*)(vp_ + (size_t)32 * d * TPB + 16 * q4); } while (0)
#define NA_LOADV1(VF, d_, tt_) do { const int p0_ = NA_POS0(tt_); const bf16_t* vp_ = vbase + (size_t)l31 * TPB + p0_ + 8 * hi; \
        _Pragma("unroll") for (int q4 = 0; q4 < 4; ++q4) VF[q4] = *(const bf16x8*)(vp_ + (size_t)32 * (d_) * TPB + 16 * q4); } while (0)
    bf16x8 kf[2][4], vf[2][4], nkf[2][4], nvf0[4];
    NA_LOADK(kf, 0); NA_LOADV1(vf[0], 0, 0);
    for (int tt = 0; tt < ntiles; ++tt) {
        const bool masked = na && tt < 8;
        NA_LOADV1(vf[1], 1, tt);
        if (tt + 1 < ntiles) { NA_LOADK(nkf, tt + 1); NA_LOADV1(nvf0, 0, tt + 1); }
        f32x16 s[2];
        { const float nm = -m;
#pragma unroll
          for (int i = 0; i < 16; ++i) { s[0][i] = nm; s[1][i] = nm; } }
#pragma unroll
        for (int kb = 0; kb < 2; ++kb) {
#pragma unroll
            for (int c = 0; c < 4; ++c) s[kb] = MFMA32(kf[kb][c], qf[c], s[kb]);
        }
        if (masked) {
            const float* trow = tab + (rs + tt - r + 7) * 128 + 63 - qc + 4 * hi;
#pragma unroll
            for (int kb = 0; kb < 2; ++kb)
#pragma unroll
                for (int i = 0; i < 16; ++i) {
                    const int kc = 32 * kb + (i & 3) + 8 * (i >> 2) + 4 * hi;
                    const bool valid = (kc >= cs) && (kc < cs + 16);
                    s[kb][i] = valid ? s[kb][i] + trow[32 * kb + (i & 3) + 8 * (i >> 2)] : -1e30f;
                }
        }
        {
            float mx = fmaxf(s[0][0], s[1][0]);
#pragma unroll
            for (int i = 1; i < 16; ++i) mx = fmaxf(fmaxf(mx, s[0][i]), s[1][i]);
            mx = fmaxf(mx, __shfl_xor(mx, 32));
            if (tt == 0 || (__builtin_amdgcn_ballot_w64(mx > 8.0f) != 0ull)) {
                const float delta = (tt == 0) ? mx : fmaxf(mx, 0.f);
                m += delta;
#pragma unroll
                for (int i = 0; i < 16; ++i) { s[0][i] -= delta; s[1][i] -= delta; }
                const float alpha = __builtin_amdgcn_exp2f(-delta);
                l *= alpha;
#pragma unroll
                for (int d = 0; d < 2; ++d)
#pragma unroll
                    for (int i = 0; i < 16; ++i) o[d][i] *= alpha;
            }
            float sum = 0.f;
#pragma unroll
            for (int i = 0; i < 16; ++i) { s[0][i] = __builtin_amdgcn_exp2f(s[0][i]); sum += s[0][i]; }
#pragma unroll
            for (int i = 0; i < 16; ++i) { s[1][i] = __builtin_amdgcn_exp2f(s[1][i]); sum += s[1][i]; }
            l += sum;
        }
#pragma unroll
        for (int kb = 0; kb < 2; ++kb)
#pragma unroll
            for (int s2 = 0; s2 < 2; ++s2) {
                const bf16x8 pf = pack8(s[kb], s2);
#pragma unroll
                for (int d = 0; d < 2; ++d) o[d] = MFMA32(vf[d][2 * kb + s2], pf, o[d]);
            }
        if (tt + 1 < ntiles) {
#pragma unroll
            for (int kb = 0; kb < 2; ++kb)
#pragma unroll
                for (int c = 0; c < 4; ++c) { kf[kb][c] = nkf[kb][c]; if (kb == 0) vf[0][c] = nvf0[c]; }
        }
    }
#undef NA_LOADK
#undef NA_LOADV
#undef NA_LOADV1
#undef NA_POS0
    const float inv = 1.0f / (l + __shfl_xor(l, 32));
    bf16_t* op = CAT + (size_t)qrow * 1024 + 512 + h * 64;
#pragma unroll
    for (int d = 0; d < 2; ++d)
#pragma unroll
        for (int g = 0; g < 4; ++g) { u32x2 w; w.x = pk2(o[d][4 * g] * inv, o[d][4 * g + 1] * inv); w.y = pk2(o[d][4 * g + 2] * inv, o[d][4 * g + 3] * inv);
            *(u32x2*)(op + 32 * d + 8 * g + 4 * hi) = w; }
}

DI void na_half(const unsigned char* Kh, const unsigned char* Vh, const int sw, const int hi, const bf16x8 (&qf)[4], f32x16& o0, f32x16& o1, float& m, float& lsum,
                const bool masked, const bool first, const float rowval, const int qc) {
    f32x16 s0, s1;
    { const float nm = -m;
#pragma unroll
      for (int i = 0; i < 16; ++i) { s0[i] = nm; s1[i] = nm; } }
#pragma unroll
    for (int c = 0; c < 4; ++c) { const bf16x8 kf = *(const bf16x8*)(Kh + (((2 * c + hi) ^ sw) << 4)); s0 = MFMA32(kf, qf[c], s0); }
#pragma unroll
    for (int c = 0; c < 4; ++c) { const bf16x8 kf = *(const bf16x8*)(Kh + 4096 + (((2 * c + hi) ^ sw) << 4)); s1 = MFMA32(kf, qf[c], s1); }
    if (masked) {
        const int cs = min(max(qc - 8, 0), 48);
        int ib = (4 * hi - qc + 15) * 4; asm volatile("" : "+v"(ib));
        int rel = cs - 4 * hi; asm volatile("" : "+v"(rel));
#pragma unroll
        for (int i = 0; i < 16; ++i) {
            const int kcc = (i & 3) + 8 * (i >> 2);
            const float b0 = __int_as_float(__builtin_amdgcn_ds_bpermute(ib + 4 * kcc, __float_as_int(rowval)));
            const float b1 = __int_as_float(__builtin_amdgcn_ds_bpermute(ib + 4 * (kcc + 32), __float_as_int(rowval)));
            s0[i] = ((unsigned)(kcc - rel) < 16u) ? s0[i] + b0 : -1e30f;
            s1[i] = ((unsigned)(kcc + 32 - rel) < 16u) ? s1[i] + b1 : -1e30f;
        }
    }
    float mx = fmaxf(s0[0], s1[0]);
#pragma unroll
    for (int i = 1; i < 16; ++i) mx = fmaxf(fmaxf(mx, s0[i]), s1[i]);
    mx = fmaxf(mx, __shfl_xor(mx, 32));
    if (first || (__builtin_amdgcn_ballot_w64(mx > 8.0f) != 0ull)) {
        const float delta = first ? mx : fmaxf(mx, 0.f);
        m += delta;
#pragma unroll
        for (int i = 0; i < 16; ++i) { s0[i] -= delta; s1[i] -= delta; }
        const float alpha = __builtin_amdgcn_exp2f(-delta);
        lsum *= alpha;
#pragma unroll
        for (int i = 0; i < 16; ++i) { o0[i] *= alpha; o1[i] *= alpha; }
    }
    float sum = 0.f;
#pragma unroll
    for (int i = 0; i < 16; ++i) { s0[i] = __builtin_amdgcn_exp2f(s0[i]); sum += s0[i]; }
#pragma unroll
    for (int i = 0; i < 16; ++i) { s1[i] = __builtin_amdgcn_exp2f(s1[i]); sum += s1[i]; }
    lsum += sum;
#pragma unroll
    for (int s2 = 0; s2 < 2; ++s2) {
        const bf16x8 pf = pack8(s0, s2);
        const bf16x8 v0 = *(const bf16x8*)(Vh + (((2 * s2 + hi) ^ sw) << 4)), v1 = *(const bf16x8*)(Vh + 4096 + (((2 * s2 + hi) ^ sw) << 4));
        o0 = MFMA32(v0, pf, o0); o1 = MFMA32(v1, pf, o1);
    }
#pragma unroll
    for (int s2 = 0; s2 < 2; ++s2) {
        const bf16x8 pf = pack8(s1, s2);
        const bf16x8 v0 = *(const bf16x8*)(Vh + (((4 + 2 * s2 + hi) ^ sw) << 4)), v1 = *(const bf16x8*)(Vh + 4096 + (((4 + 2 * s2 + hi) ^ sw) << 4));
        o0 = MFMA32(v0, pf, o0); o1 = MFMA32(v1, pf, o1);
    }
}
DI void na_store(bf16_t* op, const f32x16& o0, const f32x16& o1, const float lsum, const int hi) {
    const float inv = 1.0f / (lsum + __shfl_xor(lsum, 32));
#pragma unroll
    for (int g = 0; g < 4; ++g) {
        u32x2 w; w.x = pk2(o0[4 * g] * inv, o0[4 * g + 1] * inv); w.y = pk2(o0[4 * g + 2] * inv, o0[4 * g + 3] * inv); *(u32x2*)(op + 8 * g + 4 * hi) = w;
        w.x = pk2(o1[4 * g] * inv, o1[4 * g + 1] * inv); w.y = pk2(o1[4 * g + 2] * inv, o1[4 * g + 3] * inv); *(u32x2*)(op + 32 + 8 * g + 4 * hi) = w; }
}
DI void na_block_item(const P& p, unsigned char* shm, int j, int item, int tid) {
    const bf16_t* QK = (const bf16_t*)(p.ws + OFF_QK);
    const bf16_t* VT = (const bf16_t*)(p.ws + OFF_VT);
    bf16_t* CAT = (bf16_t*)(p.ws + OFF_CAT);
    const int h = tid >> 6, lane = tid & 63, l31 = lane & 31, hi = lane >> 5;
    const int b = item >> 6, r = item & 63;
    const int rs = min(max(r - 4, 0), 56);
    const float* rpb = p.in[12] + (size_t)(j * 8 + h) * 15 * 31;
    bf16x8 qa[4], qb[4];
#pragma unroll
    for (int c = 0; c < 4; ++c) { qa[c] = *(const bf16x8*)(QK + (size_t)(b * TPB + 256 + r * 64 + l31) * 1024 + h * 64 + 16 * c + 8 * hi);
                                  qb[c] = *(const bf16x8*)(QK + (size_t)(b * TPB + 256 + r * 64 + 32 + l31) * 1024 + h * 64 + 16 * c + 8 * hi); }
    f32x16 oa0, oa1, ob0, ob1; float ma = 0.f, mb = 0.f, la = 0.f, lb = 0.f;
#pragma unroll
    for (int i = 0; i < 16; ++i) { oa0[i] = 0.f; oa1[i] = 0.f; ob0[i] = 0.f; ob1[i] = 0.f; }
    const int sw = (l31 >> 1) & 7;
    const unsigned char* Kh = shm + h * 8192 + l31 * 128;
    const unsigned char* Vh = shm + 65536 + h * 8192 + l31 * 128;
    for (int tt = 0; tt < 12; ++tt) {
        const bool masked = tt < 8;
        const int pos0 = masked ? 256 + (rs + tt) * 64 : (tt - 8) * 64;
        __syncthreads();
        {
            int tl = tid; asm volatile("" : "+v"(tl));
            const int krow = tl >> 6, kcb = tl & 63;
            const int kdst = (kcb >> 3) * 8192 + krow * 128;
            const int vrow = tl >> 3, vch = tl & 7;
            const int vdst = 65536 + vrow * 128 + ((vch ^ ((vrow >> 1) & 7)) << 4);
            const bf16_t* ks = QK + (size_t)(b * TPB + pos0 + krow) * 1024 + 512 + kcb * 8;
            const bf16_t* vs = VT + (size_t)((b * 8) * 64 + vrow) * TPB + pos0 + vch * 8;
            u32x4 tk[8], tv[8];
#pragma unroll
            for (int i = 0; i < 8; ++i) tk[i] = *(const u32x4*)(ks + (size_t)i * 8 * 1024);
#pragma unroll
            for (int i = 0; i < 8; ++i) tv[i] = *(const u32x4*)(vs + (size_t)i * 64 * TPB);
#pragma unroll
            for (int i = 0; i < 8; ++i) { const int row = krow + 8 * i; *(u32x4*)(shm + kdst + i * 1024 + (((kcb & 7) ^ ((row >> 1) & 7)) << 4)) = tk[i]; }
#pragma unroll
            for (int i = 0; i < 8; ++i) *(u32x4*)(shm + vdst + i * 8192) = tv[i];
        }
        __syncthreads();
        float rowval = 0.f;
        if (masked) rowval = rpb[(rs + tt - r + 7) * 31 + min(lane, 30)] * LOG2E;
        __builtin_amdgcn_sched_barrier(0);
        na_half(Kh, Vh, sw, hi, qa, oa0, oa1, ma, la, masked, tt == 0, rowval, l31);
        __builtin_amdgcn_sched_barrier(0);
        na_half(Kh, Vh, sw, hi, qb, ob0, ob1, mb, lb, masked, tt == 0, rowval, 32 + l31);
        __builtin_amdgcn_sched_barrier(0);
    }
    {
        int t2 = tid; asm volatile("" : "+v"(t2));
        const int h2 = t2 >> 6, l2 = t2 & 31, hi2 = (t2 >> 5) & 1;
        bf16_t* op = CAT + (size_t)(b * TPB + 256 + r * 64 + l2) * 1024 + 512 + h2 * 64;
        na_store(op, oa0, oa1, la, hi2);
        na_store(op + (size_t)32 * 1024, ob0, ob1, lb, hi2);
    }
    __syncthreads();
}

constexpr int DA_ROW = 144, DA_KBYTES = 2 * 64 * DA_ROW, DA_STAGE = DA_KBYTES + 128 * DA_ROW;
DI void diff_item(const P& p, unsigned char* shm, int l, int bh, int qrow0, int nkt, float lam, float lam_init, int tid) {
    const bf16_t* QK = (const bf16_t*)(p.ws + OFF_QK);
    const bf16_t* VT = (const bf16_t*)(p.ws + OFF_VT);
    bf16_t* CAT = (bf16_t*)(p.ws + OFF_CAT);
    const int j = l >> 1;
    const int wv = tid >> 6, lane = tid & 63, l31 = lane & 31, hi = lane >> 5, sub = wv >> 2, qw = wv & 3;
    const int b = bh >> 3, h = bh & 7;
    const int qrow = qrow0 + 32 * qw + l31;
    bf16x8 qf[4];
#pragma unroll
    for (int c = 0; c < 4; ++c) qf[c] = *(const bf16x8*)(QK + (size_t)qrow * 2048 + h * 128 + sub * 64 + 16 * c + 8 * hi);
    const bf16_t* ksrc[2]; const bf16_t* vsrc[2]; int kdst[2], vdst[2];
#pragma unroll
    for (int i = 0; i < 2; ++i) { const int id = tid + 512 * i; const int row = id >> 4, cb = id & 15;
        ksrc[i] = QK + (size_t)(b * TPB + row) * 2048 + 1024 + h * 128 + cb * 8; kdst[i] = ((cb >> 3) * 64 + row) * DA_ROW + (cb & 7) * 16;
        const int d = id >> 3, pc = id & 7;
        vsrc[i] = VT + (size_t)(bh * 128 + d) * TPB + pc * 8; vdst[i] = DA_KBYTES + d * DA_ROW + pc * 16; }
    u32x4 pre[4];
    {
        u32x4 pre1[4];
#pragma unroll
        for (int i = 0; i < 2; ++i) { pre[i] = *(const u32x4*)(ksrc[i]); pre[2 + i] = *(const u32x4*)(vsrc[i]); pre1[i] = *(const u32x4*)(ksrc[i] + (size_t)64 * 2048); pre1[2 + i] = *(const u32x4*)(vsrc[i] + 64); }
#pragma unroll
        for (int i = 0; i < 2; ++i) { *(u32x4*)(shm + kdst[i]) = pre[i]; *(u32x4*)(shm + vdst[i]) = pre[2 + i]; *(u32x4*)(shm + DA_STAGE + kdst[i]) = pre1[i]; *(u32x4*)(shm + DA_STAGE + vdst[i]) = pre1[2 + i]; }
    }
    __syncthreads();
    f32x16 o[4]; float m = 0.f, lsum = 0.f;
#pragma unroll
    for (int d = 0; d < 4; ++d)
#pragma unroll
        for (int i = 0; i < 16; ++i) o[d][i] = 0.f;
    const int koff = sub * 64 * DA_ROW + l31 * DA_ROW + 16 * hi;
    const int voff = DA_KBYTES + l31 * DA_ROW + 16 * hi;
    f32x16 s[2], sn[2];
#pragma unroll
    for (int kb = 0; kb < 2; ++kb)
#pragma unroll
        for (int c = 0; c < 4; ++c) { const bf16x8 kf = *(const bf16x8*)(shm + koff + 32 * kb * DA_ROW + 32 * c); if (c == 0) { _Pragma("unroll") for (int i = 0; i < 16; ++i) s[kb][i] = 0.f; } s[kb] = MFMA32(kf, qf[c], s[kb]); }
    float mx = fmaxf(s[0][0], s[1][0]);
#pragma unroll
    for (int i = 1; i < 16; ++i) mx = fmaxf(fmaxf(mx, s[0][i]), s[1][i]);
    mx = fmaxf(mx, __shfl_xor(mx, 32));
    int st_cur = 0, st_nxt = DA_STAGE, st_ld = 2 * DA_STAGE;
    for (int kt = 0; kt < nkt; ++kt) {
        const bool more = (kt + 2 < nkt);
        if (more) {
#pragma unroll
            for (int i = 0; i < 2; ++i) { pre[i] = *(const u32x4*)(ksrc[i] + (size_t)(kt + 2) * 64 * 2048); pre[2 + i] = *(const u32x4*)(vsrc[i] + (kt + 2) * 64); }
        }
        if (kt == 0 || (__builtin_amdgcn_ballot_w64(mx > 8.0f) != 0ull)) {
            const float delta = (kt == 0) ? mx : fmaxf(mx, 0.f);
            m += delta;
#pragma unroll
            for (int i = 0; i < 16; ++i) { s[0][i] -= delta; s[1][i] -= delta; }
            const float alpha = __builtin_amdgcn_exp2f(-delta);
            lsum *= alpha;
#pragma unroll
            for (int d = 0; d < 4; ++d)
#pragma unroll
                for (int i = 0; i < 16; ++i) o[d][i] *= alpha;
        }
        if (sub == 0) __builtin_amdgcn_s_setprio(1);
        const unsigned char* Kn = shm + st_nxt + koff;
        const unsigned char* Vc = shm + st_cur + voff;
        bf16x8 kf[8];
#pragma unroll
        for (int kb = 0; kb < 2; ++kb)
#pragma unroll
            for (int c = 0; c < 4; ++c) kf[kb * 4 + c] = *(const bf16x8*)(Kn + 32 * kb * DA_ROW + 32 * c);
        { const float nm = -m;
#pragma unroll
          for (int i = 0; i < 16; ++i) { sn[0][i] = nm; sn[1][i] = nm; } }
        __builtin_amdgcn_sched_barrier(0);
#pragma unroll
        for (int kb = 0; kb < 2; ++kb)
#pragma unroll
            for (int c = 0; c < 4; ++c) sn[kb] = MFMA32(kf[kb * 4 + c], qf[c], sn[kb]);
        float sum = 0.f;
#pragma unroll
        for (int i = 0; i < 16; ++i) { s[0][i] = __builtin_amdgcn_exp2f(s[0][i]); sum += s[0][i]; }
        const bf16x8 p00 = pack8(s[0], 0), p01 = pack8(s[0], 1);
        __builtin_amdgcn_sched_barrier(0);
        bf16x8 vf[8];
#pragma unroll
        for (int d = 0; d < 4; ++d) { vf[2 * d] = *(const bf16x8*)(Vc + 32 * d * DA_ROW); vf[2 * d + 1] = *(const bf16x8*)(Vc + 32 * d * DA_ROW + 32); }
        __builtin_amdgcn_sched_barrier(0);
#pragma unroll
        for (int d = 0; d < 4; ++d) { o[d] = MFMA32(vf[2 * d], p00, o[d]); o[d] = MFMA32(vf[2 * d + 1], p01, o[d]); }
#pragma unroll
        for (int i = 0; i < 16; ++i) { s[1][i] = __builtin_amdgcn_exp2f(s[1][i]); sum += s[1][i]; }
        lsum += sum;
        const bf16x8 p10 = pack8(s[1], 0), p11 = pack8(s[1], 1);
        __builtin_amdgcn_sched_barrier(0);
#pragma unroll
        for (int d = 0; d < 4; ++d) { vf[2 * d] = *(const bf16x8*)(Vc + 32 * d * DA_ROW + 64); vf[2 * d + 1] = *(const bf16x8*)(Vc + 32 * d * DA_ROW + 96); }
        __builtin_amdgcn_sched_barrier(0);
#pragma unroll
        for (int d = 0; d < 4; ++d) { o[d] = MFMA32(vf[2 * d], p10, o[d]); o[d] = MFMA32(vf[2 * d + 1], p11, o[d]); }
        __builtin_amdgcn_s_setprio(0);
        mx = fmaxf(sn[0][0], sn[1][0]);
#pragma unroll
        for (int i = 1; i < 16; ++i) mx = fmaxf(fmaxf(mx, sn[0][i]), sn[1][i]);
        mx = fmaxf(mx, __shfl_xor(mx, 32));
        if (more) {
#pragma unroll
            for (int i = 0; i < 2; ++i) { *(u32x4*)(shm + st_ld + kdst[i]) = pre[i]; *(u32x4*)(shm + st_ld + vdst[i]) = pre[2 + i]; }
        }
        __syncthreads();
        s[0] = sn[0]; s[1] = sn[1];
        const int t_ = st_cur; st_cur = st_nxt; st_nxt = st_ld; st_ld = t_;
    }
    const float inv = 1.0f / (lsum + __shfl_xor(lsum, 32));
    f32x4* xch = (f32x4*)shm;
    if (sub == 1) {
#pragma unroll
        for (int d = 0; d < 4; ++d)
#pragma unroll
            for (int g = 0; g < 4; ++g) xch[(qw * 16 + d * 4 + g) * 64 + lane] = (f32x4){o[d][4 * g] * inv, o[d][4 * g + 1] * inv, o[d][4 * g + 2] * inv, o[d][4 * g + 3] * inv};
    }
    __syncthreads();
    if (sub == 0) {
        int lq = l; asm volatile("" : "+s"(lq));
        const float lam2 = ((const float*)(p.ws + OFF_LAM))[lq >> 1];
        const float lam_init2 = 0.8f - 0.6f * expf(-0.3f * (float)lq);
        float ss = 0.f;
#pragma unroll
        for (int d = 0; d < 4; ++d)
#pragma unroll
            for (int g = 0; g < 4; ++g) { const f32x4 o2 = xch[(qw * 16 + d * 4 + g) * 64 + lane];
#pragma unroll
                for (int i = 0; i < 4; ++i) { const float y = o[d][4 * g + i] * inv - lam2 * o2[i]; o[d][4 * g + i] = y; ss += y * y; } }
        ss += __shfl_xor(ss, 32);
        const float rn = rsqrtf(ss * (1.0f / 128.0f) + 1e-5f) * (1.0f - lam_init2);
        const float* sg = p.in[19] + j * 128;
        bf16_t* op = CAT + (size_t)qrow * 1024 + h * 128;
#pragma unroll
        for (int d = 0; d < 4; ++d)
#pragma unroll
            for (int g = 0; g < 4; ++g) { const int d0 = 32 * d + 8 * g + 4 * hi; const f32x4 gg = *(const f32x4*)(sg + d0);
                u32x2 w; w.x = pk2(o[d][4 * g] * rn * gg[0], o[d][4 * g + 1] * rn * gg[1]); w.y = pk2(o[d][4 * g + 2] * rn * gg[2], o[d][4 * g + 3] * rn * gg[3]);
                *(u32x2*)(op + d0) = w; }
    }
    __syncthreads();
}

DI void transpose_item(const float* W, int ldw, bf16_t* WT, int K, int item, int nblk, float* scr, int lane) {
    const int kb = item / nblk, nb = item % nblk, k0 = 64 * kb, n0 = 32 * nb;
#pragma unroll 8
    for (int i = 0; i < 32; ++i) { const int kk = 2 * i + (lane >> 5); scr[kk * 33 + (lane & 31)] = __builtin_nontemporal_load(W + (size_t)(k0 + kk) * ldw + n0 + (lane & 31)); }
    __builtin_amdgcn_wave_barrier();
    const int c = lane & 7;
#pragma unroll
    for (int jx = 0; jx < 4; ++jx) { const int n = (lane >> 3) + 8 * jx; const float* s = scr + (8 * c) * 33 + n;
        u32x4 o; o.x = pk2(s[0 * 33], s[1 * 33]); o.y = pk2(s[2 * 33], s[3 * 33]); o.z = pk2(s[4 * 33], s[5 * 33]); o.w = pk2(s[6 * 33], s[7 * 33]);
        *(u32x4*)(WT + (size_t)(n0 + n) * K + k0 + 8 * c) = o; }
    __builtin_amdgcn_wave_barrier();
}

DI void phase0(const P& p, unsigned char* shm, int tid) {
    float* ldsf = (float*)shm;
    const int wv = tid >> 6, lane = tid & 63;
    const int G = gridDim.x, blk = blockIdx.x;
    float* MOD = (float*)(p.ws + OFF_MOD);
    {
        for (int i = tid; i < 5120; i += 512) { const int r = i >> 10, k = i & 1023; const float v = r < 4 ? p.in[1][r * 1024 + k] : p.in[3][k]; ldsf[i] = v / (1.0f + expf(-v)); }
        __syncthreads();
        float* red = ldsf + 5120;
        const int col32 = lane & 31, ksub = lane >> 5;
        for (int item = blk; item < 768; item += G) {
            const int l = item / 192, n0 = (item % 192) * 32;
            const float* W = p.in[4] + (size_t)l * 1024 * 6144 + n0 + col32;
            float a0 = 0.f, a1 = 0.f, a2 = 0.f, a3 = 0.f, a4 = 0.f;
#pragma unroll 8
            for (int i = 0; i < 64; ++i) { const int k = wv * 128 + 2 * i + ksub; const float w = __builtin_nontemporal_load(W + (size_t)k * 6144);
                a0 += ldsf[k] * w; a1 += ldsf[1024 + k] * w; a2 += ldsf[2048 + k] * w; a3 += ldsf[3072 + k] * w; a4 += ldsf[4096 + k] * w; }
            a0 += __shfl_xor(a0, 32); a1 += __shfl_xor(a1, 32); a2 += __shfl_xor(a2, 32); a3 += __shfl_xor(a3, 32); a4 += __shfl_xor(a4, 32);
            if (lane < 32) { red[(wv * 5 + 0) * 32 + lane] = a0; red[(wv * 5 + 1) * 32 + lane] = a1; red[(wv * 5 + 2) * 32 + lane] = a2; red[(wv * 5 + 3) * 32 + lane] = a3; red[(wv * 5 + 4) * 32 + lane] = a4; }
            __syncthreads();
            if (tid < 160) { const int r = tid >> 5, cl = tid & 31; float s = 0.f;
#pragma unroll
                for (int w = 0; w < 8; ++w) s += red[(w * 5 + r) * 32 + cl];
                MOD[(size_t)(l * 5 + r) * 6144 + n0 + cl] = s + p.in[5][l * 6144 + n0 + cl]; }
            __syncthreads();
        }
    }
    {
        float* tile = ldsf; float* tabc = ldsf + 8192; float* tabs = ldsf + 8320;
        if (tid < 128) { tabc[tid] = cospif((float)tid * (1.0f / 64.0f)); tabs[tid] = sinpif((float)tid * (1.0f / 64.0f)); }
        for (int item = blk; item < 128; item += G) {
            const int jj = item >> 6, g = (item >> 4) & 3, k0 = (item & 15) * 64;
            __syncthreads();
#pragma unroll
            for (int i = 0; i < 16; ++i) { const int idx = tid + 512 * i; const int row = idx >> 7, col = idx & 127; tile[idx] = p.in[10][(size_t)jj * 1024 * 2048 + (size_t)(k0 + row) * 2048 + g * 128 + col]; }
            __syncthreads();
            const int c = tid >> 2, kq = tid & 3;
            float ac[16], as[16];
#pragma unroll
            for (int i = 0; i < 16; ++i) { ac[i] = 0.f; as[i] = 0.f; }
            for (int cp = 0; cp < 128; ++cp) { const int idx = (c * cp) & 127; const float tc = tabc[idx], ts = tabs[idx];
#pragma unroll
                for (int kk = 0; kk < 16; ++kk) { const float x = tile[(kq * 16 + kk) * 128 + cp]; ac[kk] += x * tc; as[kk] += x * ts; } }
            bf16_t* WT = (bf16_t*)(p.ws + OFF_WINAB) + (size_t)jj * 2560 * 1024;
            u32x4 w0, w1;
            w0.x = pk2(ac[0], ac[1]); w0.y = pk2(ac[2], ac[3]); w0.z = pk2(ac[4], ac[5]); w0.w = pk2(ac[6], ac[7]);
            w1.x = pk2(ac[8], ac[9]); w1.y = pk2(ac[10], ac[11]); w1.z = pk2(ac[12], ac[13]); w1.w = pk2(ac[14], ac[15]);
            u32x4* d0 = (u32x4*)(WT + (size_t)(g * 128 + c) * 1024 + k0 + kq * 16); d0[0] = w0; d0[1] = w1;
            w0.x = pk2(as[0], as[1]); w0.y = pk2(as[2], as[3]); w0.z = pk2(as[4], as[5]); w0.w = pk2(as[6], as[7]);
            w1.x = pk2(as[8], as[9]); w1.y = pk2(as[10], as[11]); w1.z = pk2(as[12], as[13]); w1.w = pk2(as[14], as[15]);
            u32x4* d1 = (u32x4*)(WT + (size_t)(512 + g * 128 + c) * 1024 + k0 + kq * 16); d1[0] = w0; d1[1] = w1;
        }
    }
    __syncthreads();
    {
        float* scr = ldsf + 8192 + wv * 2112;
        unsigned* t1ctr = (unsigned*)(p.ws + OFF_CTL) + 16;
        for (;;) {
            unsigned itu = 0;
            if (lane == 0) itu = __hip_atomic_fetch_add(t1ctr, 1u, __ATOMIC_RELAXED, __HIP_MEMORY_SCOPE_AGENT);
            const int chunk = __builtin_amdgcn_readfirstlane((int)itu);
            if (chunk >= 1536) break;
            for (int it = chunk * 15; it < chunk * 15 + 15; ++it) {
            int r = it; const float* W; int ldw, K, nblk; bf16_t* WT;
            if (r < 1536) { const int jj = r / 768; r %= 768; W = p.in[10] + (size_t)jj * 1024 * 2048 + 512; ldw = 2048; WT = (bf16_t*)(p.ws + OFF_WINAB) + ((size_t)jj * 2560 + 1024) * 1024; K = 1024; nblk = 48; }
            else if ((r -= 1536) < 1024) { const int jj = r / 512; r %= 512; W = p.in[11] + (size_t)jj * 1024 * 1024; ldw = 1024; WT = (bf16_t*)(p.ws + OFF_WOUTAB) + (size_t)jj * 1024 * 1024; K = 1024; nblk = 32; }
            else if ((r -= 1024) < 3072) { const int jj = r / 1536; r %= 1536; W = p.in[13] + (size_t)jj * 1024 * 3072; ldw = 3072; WT = (bf16_t*)(p.ws + OFF_WQKV) + (size_t)jj * 3072 * 1024; K = 1024; nblk = 96; }
            else if ((r -= 3072) < 1024) { const int jj = r / 512; r %= 512; W = p.in[14] + (size_t)jj * 1024 * 1024; ldw = 1024; WT = (bf16_t*)(p.ws + OFF_WOUTD) + (size_t)jj * 1024 * 1024; K = 1024; nblk = 32; }
            else if ((r -= 1024) < 8192) { const int ll = r / 2048; r %= 2048; W = p.in[8] + (size_t)ll * 1024 * 4096; ldw = 4096; WT = (bf16_t*)(p.ws + OFF_WMI) + (size_t)ll * 4096 * 1024; K = 1024; nblk = 128; }
            else { r -= 8192; const int ll = r / 2048; r %= 2048; W = p.in[9] + (size_t)ll * 4096 * 1024; ldw = 1024; WT = (bf16_t*)(p.ws + OFF_WMO) + (size_t)ll * 1024 * 4096; K = 4096; nblk = 32; }
            transpose_item(W, ldw, WT, K, r, nblk, scr, lane);
            }
        }
    }
    __syncthreads();
    {
        float* tab = ldsf;
        for (int i = tid; i < 4096; i += 512) tab[i] = cospif((float)i * (1.0f / 2048.0f));
        __syncthreads();
        bf16_t* D1 = (bf16_t*)(p.ws + OFF_D128);
        for (int idx = blk * 512 + tid; idx < 65536; idx += G * 512) {
            const int n = idx >> 8, k = idx & 255; const int mm = ((n & 127) * (k & 127)) & 127;
            const float c = tab[(32 * mm) & 4095], sn = tab[(32 * mm - 1024) & 4095];
            const float val = (n < 128) ? (k < 128 ? c : sn) : (k < 128 ? -sn : c);
            D1[idx] = bf1(val);
        }
        bf16_t* DC = (bf16_t*)(p.ws + OFF_DFTC);
        for (int row = blk; row < 256; row += G) {
            if (tid < 32) { const int n0 = tid * 8; float c8[8], s8[8];
#pragma unroll
                for (int e = 0; e < 8; ++e) { const int idx = (16 * row * (n0 + e)) & 4095; c8[e] = tab[idx]; s8[e] = -tab[(idx - 1024) & 4095]; }
                u32x4 w; w.x = pk2(c8[0], c8[1]); w.y = pk2(c8[2], c8[3]); w.z = pk2(c8[4], c8[5]); w.w = pk2(c8[6], c8[7]);
                *(u32x4*)(DC + (size_t)row * 512 + n0) = w;
                w.x = pk2(s8[0], s8[1]); w.y = pk2(s8[2], s8[3]); w.z = pk2(s8[4], s8[5]); w.w = pk2(s8[6], s8[7]);
                *(u32x4*)(DC + (size_t)row * 512 + 256 + n0) = w; }
        }
    }
    if (blk == G - 1) {
        float* rope = (float*)(p.ws + OFF_ROPE);
        for (int i = tid; i < 1024; i += 512) { const int pos = i >> 4, jf = i & 15; const float inv = powf(10000.0f, -(float)jf / 16.0f); const float ang = (float)pos * inv; rope[2 * i] = cosf(ang); rope[2 * i + 1] = sinf(ang); }
        if (tid < 2) { float s1 = 0.f, s2 = 0.f; for (int d = 0; d < 64; ++d) { s1 += p.in[15][tid * 64 + d] * p.in[16][tid * 64 + d]; s2 += p.in[17][tid * 64 + d] * p.in[18][tid * 64 + d]; }
            const float lam_init = 0.8f - 0.6f * expf(-0.3f * (float)(2 * tid + 1));
            ((float*)(p.ws + OFF_LAM))[tid] = expf(s1) - expf(s2) + lam_init; }
    }
}

DI void phase0b(const P& p, int tid) {
    const int wv = tid >> 6, lane = tid & 63;
    const int gw = blockIdx.x * 8 + wv, NGW = gridDim.x * 8;
    const float* MOD = (const float*)(p.ws + OFF_MOD);
    {
        bf16_t* XB = (bf16_t*)(p.ws + OFF_XB); float* RSQ = (float*)(p.ws + OFF_RSQ16);
        for (int row = gw; row < NROWS; row += NGW) {
            const int b = row / TPB, tall = row % TPB; const bool isctx = tall < 256; const int bsel = isctx ? 4 : b;
            const float* src = isctx ? p.in[2] + (size_t)(b * 256 + tall) * 1024 : p.in[0] + (size_t)(b * 4096 + tall - 256) * 1024;
            const float* sc = MOD + (size_t)bsel * 6144 + 1024;
            float ss = 0.f;
#pragma unroll
            for (int jj = 0; jj < 4; ++jj) { const int n = 4 * lane + 256 * jj; const f32x4 v = __builtin_nontemporal_load((const f32x4*)(src + n));
                const f32x4 gs = *(const f32x4*)(p.in[6] + n) * (*(const f32x4*)(sc + n) + 1.0f); const f32x4 y = v * gs;
                ss += (v[0] * v[0] + v[1] * v[1]) + (v[2] * v[2] + v[3] * v[3]);
                u32x2 w; w.x = pk2(y[0], y[1]); w.y = pk2(y[2], y[3]); *(u32x2*)(XB + (size_t)row * 1024 + n) = w; }
            ss = wave_sum(ss);
            if (lane < 16) RSQ[(size_t)row * 16 + lane] = (lane == 0) ? ss : 0.f;
        }
    }
    {
        for (int it = gw; it < 28672; it += NGW) {
            const bf16_t* wt; const float* sh; float* out; int ostride;
            if (it < 12288) { const int l = it / 3072, n = it % 3072; const int jj = l >> 1; const bool odd = l & 1; if (!odd && n >= 2560) continue;
                wt = odd ? (const bf16_t*)(p.ws + OFF_WQKV) + ((size_t)jj * 3072 + n) * 1024 : (const bf16_t*)(p.ws + OFF_WINAB) + ((size_t)jj * 2560 + n) * 1024;
                sh = MOD + (size_t)l * 5 * 6144; out = (float*)(p.ws + OFF_SWMIX) + (size_t)l * 5 * 3072 + n; ostride = 3072; }
            else { const int r = it - 12288; const int l = r / 4096, n = r % 4096;
                wt = (const bf16_t*)(p.ws + OFF_WMI) + ((size_t)l * 4096 + n) * 1024;
                sh = MOD + (size_t)l * 5 * 6144 + 3072; out = (float*)(p.ws + OFF_SWMLP) + (size_t)l * 5 * 4096 + n; ostride = 4096; }
            const u32x4 wa = *(const u32x4*)(wt + lane * 16), wb = *(const u32x4*)(wt + lane * 16 + 8);
            float wf[16];
            wf[0] = __uint_as_float(wa.x << 16); wf[1] = __uint_as_float(wa.x & 0xffff0000u); wf[2] = __uint_as_float(wa.y << 16); wf[3] = __uint_as_float(wa.y & 0xffff0000u);
            wf[4] = __uint_as_float(wa.z << 16); wf[5] = __uint_as_float(wa.z & 0xffff0000u); wf[6] = __uint_as_float(wa.w << 16); wf[7] = __uint_as_float(wa.w & 0xffff0000u);
            wf[8] = __uint_as_float(wb.x << 16); wf[9] = __uint_as_float(wb.x & 0xffff0000u); wf[10] = __uint_as_float(wb.y << 16); wf[11] = __uint_as_float(wb.y & 0xffff0000u);
            wf[12] = __uint_as_float(wb.z << 16); wf[13] = __uint_as_float(wb.z & 0xffff0000u); wf[14] = __uint_as_float(wb.w << 16); wf[15] = __uint_as_float(wb.w & 0xffff0000u);
#pragma unroll
            for (int r = 0; r < 5; ++r) { const float* s = sh + (size_t)r * 6144 + lane * 16; float a = 0.f;
#pragma unroll
                for (int q = 0; q < 4; ++q) { const f32x4 sv = *(const f32x4*)(s + 4 * q); a += sv[0] * wf[4 * q] + sv[1] * wf[4 * q + 1] + sv[2] * wf[4 * q + 2] + sv[3] * wf[4 * q + 3]; }
                a = wave_sum(a);
                if (lane == 0) out[(size_t)r * ostride] = a; }
        }
    }
}

__global__ __launch_bounds__(512, 2) void mega(P p) {
    extern __shared__ __attribute__((aligned(16))) unsigned char shm[];
    cg::grid_group grid = cg::this_grid();
    const int G = gridDim.x, blk = blockIdx.x;
    uint4& xb_words = *(uint4*)(shm + 131072);
    int wave_s = __builtin_amdgcn_readfirstlane((int)(threadIdx.x >> 6));
    if (threadIdx.x == 0) xb_words = make_uint4(0u, 0u, 0u, 0u);
    __syncthreads();
    (void)xcd_barrier_post((unsigned*)(p.ws + OFF_BAR), (volatile LAS unsigned*)&xb_words);
#define GRID_BARRIER() do { XcdBarrier xb_; unsigned z_ = 0u; asm volatile("" : "+s"(z_)); unsigned char* w_ = p.ws + z_; xb_.bar = (unsigned*)(w_ + OFF_BAR); xb_.x = xb_xcc_id(); xb_.st = (volatile LAS unsigned*)&xb_words; xcd_barrier(xb_, get_tid(wave_s)); } while (0)
    { asm volatile("" : "+s"(wave_s)); const int tid = get_tid(wave_s);
#ifndef NO_P0
    phase0(p, shm, tid);
#ifdef X_PRO_TWICE
    __syncthreads(); phase0(p, shm, tid);
#endif
#endif
    }
    grid.sync();
    { asm volatile("" : "+s"(wave_s)); const int tid = get_tid(wave_s);
#ifndef NO_P0
    phase0b(p, tid);
#endif
    }
    GRID_BARRIER();
    float* MOD = (float*)(p.ws + OFF_MOD);
    for (int ph = 0; ph < 24; ++ph) {
        asm volatile("" : "+s"(wave_s)); const int tid = get_tid(wave_s);
        const int l = ph / 6, s6 = ph % 6, j = l >> 1; const bool odd = (l & 1) != 0;
        const int s = (s6 == 2) ? 9 : (s6 < 2 ? s6 : s6 - 1);
        if (s == 9 && odd) continue;
        const int nops = (s == 1) ? (odd ? 0 : 1) : 1;
        for (int oi = 0; oi < nops; ++oi) {
            pg8::Gemm g; EpiPg8 EP; Epi& E = EP.E; int rot = 0, skip = 1;
            E.mode = 0; EP.perm = 1; E.perm = 1; E.l = l; E.s = s; E.wsp = p.ws; E.outp = p.out; E.in0 = p.in[0]; E.in2 = p.in[2]; E.in6 = p.in[6]; E.in7 = p.in[7];
            if (s == 0) {
                g.A = (const bf16_t*)(p.ws + OFF_XB); g.M = 16384; g.K = 1024;
                if (odd) { g.Bt = (const bf16_t*)(p.ws + OFF_WQKV) + (size_t)j * 3072 * 1024; g.N = 3072; E.mode = 1; }
                else { g.Bt = (const bf16_t*)(p.ws + OFF_WINAB) + (size_t)j * 2560 * 1024; g.N = 2560; E.mode = 0; g.M = NROWS; skip = 0; }
            } else if (s == 1) {
                skip = 0; g.A = (const bf16_t*)(p.ws + OFF_DFTC); g.Bt = (const bf16_t*)(p.ws + OFF_FTC); g.M = 256; g.N = 2048; g.K = 512; E.mode = 5;
            } else if (s == 9) {
                skip = 0; g.A = (const bf16_t*)(p.ws + OFF_TP); g.Bt = (const bf16_t*)(p.ws + OFF_D128); g.M = 65536; g.N = 256; g.K = 256; E.mode = 4;
            } else if (s == 2) {
                g.A = (const bf16_t*)(p.ws + OFF_CAT); g.Bt = (odd ? (const bf16_t*)(p.ws + OFF_WOUTD) : (const bf16_t*)(p.ws + OFF_WOUTAB)) + (size_t)j * 1024 * 1024; g.M = 16384; g.N = 1024; g.K = 1024;
                E.mode = 3;
            } else if (s == 3) {
                g.A = (const bf16_t*)(p.ws + OFF_XB); g.Bt = (const bf16_t*)(p.ws + OFF_WMI) + (size_t)l * 4096 * 1024; g.M = 16384; g.N = 4096; g.K = 1024;
                E.mode = 2;
            } else {
                g.A = (const bf16_t*)(p.ws + OFF_U); g.Bt = (const bf16_t*)(p.ws + OFF_WMO) + (size_t)l * 1024 * 4096; g.M = 16384; g.N = 1024; g.K = 4096;
                E.mode = 3;
            }
            pg8::StaticOrder S; S.init(g.M, g.N, G, (blk + rot) % G, skip);
            const bool has_mini = (s != 1 && s != 9 && (l < 3 || s == 0)) && !(s == 0 && !odd);
            const bool mini_first = ((blk >> 3) & 1) != 0;
            for (int pass = 0; pass < 2; ++pass) {
                if (has_mini && (pass == 0) == mini_first) {
                    const int nmt = 16 * (g.N >> 6);
                    const int tid3 = get_tid(wave_s);
                    if (g.K == 1024) mini_gemm_seq1024(E, g.A, g.Bt, (blk + 128) % G + ((l == 3 && s == 0) ? 256 : 0), nmt, G, shm, tid3);
                    else for (int mt = (blk + 128) % G; mt < nmt; mt += G) mini_gemm_tile(E, g.A, g.Bt, g.K, mt, shm, tid3);
                }
                if (pass == 0) {
                    const int tidg = get_tid(wave_s);
                    pg8::gemm_phase(( LAS unsigned char*)shm, g, S, EP, tidg);
                }
            }
        }
        if (s == 1 && !odd) {
            unsigned z2 = 0u; asm volatile("" : "+s"(z2)); unsigned char* w2 = p.ws + z2;
            const int tidf = get_tid(wave_s);
            for (int it = (blk + 248) % G; it < 512; it += G) fft_stage1_item(w2, it, tidf);
        }
        if (s == 1 || s == 9) {
            if (!odd) {
                unsigned* ctr = (unsigned*)(p.ws + OFF_CTL) + l;
                if (s == 1) { const int tidb = get_tid(wave_s); for (int bi = blk; bi < 256; bi += G) na_block_item(p, shm, j, bi, tidb); }
                const int tidn = get_tid(wave_s);
                const int lane = tidn & 63;
                for (;;) {
                    unsigned it = 0;
                    if (lane == 0) it = __hip_atomic_fetch_add(ctr, 1u, __ATOMIC_RELAXED, __HIP_MEMORY_SCOPE_AGENT);
                    it = (unsigned)__builtin_amdgcn_readfirstlane((int)it) + 4096u;
                    if (it >= 4096u + 256u) break;
#ifndef NO_NA
                    na_item<false>(p, shm, tidn >> 6, j, it, lane);
#endif
                }
            } else {
                const int tidd = get_tid(wave_s);
                const float lam = ((const float*)(p.ws + OFF_LAM))[j];
                const float lam_init = 0.8f - 0.6f * expf(-0.3f * (float)l);
                const int nitems = 1024 + (l < 3 ? 64 : 0);
                for (int v = blk; v < nitems; v += G) {
                    int bh, qrow0, nkt;
                    if (v < 1024) { const int rd = v >> 8, w = v & 255; bh = rd * 8 + (w & 7); const int qb = w >> 3; qrow0 = (bh >> 3) * TPB + 256 + qb * 128; nkt = 68; }
                    else { const int c = v - 1024; bh = c >> 1; qrow0 = (bh >> 3) * TPB + (c & 1) * 128; nkt = 4; }
#ifndef NO_DIFF
                    diff_item(p, shm, l, bh, qrow0, nkt, lam, lam_init, tidd);
#ifdef X_DIFF_TWICE
                    diff_item(p, shm, l, bh, qrow0, nkt, lam, lam_init, tidd);
#endif
#endif
                }
            }
        }
        GRID_BARRIER();
#ifdef X_EXTRA_SYNC
        GRID_BARRIER();
#endif
    }
    {
        asm volatile("" : "+s"(wave_s)); const int tid = get_tid(wave_s);
        const int wv = tid >> 6, lane = tid & 63;
        const float* rs = (const float*)(p.ws + OFF_RSQ16) + (size_t)8 * NROWS * 16;
        for (int row = blk * 8 + wv; row < 16384; row += G * 8) {
            const int b = row >> 12, t = row & 4095;
            const f32x4* q4 = (const f32x4*)(rs + (size_t)(b * TPB + 256 + t) * 16);
            const f32x4 tq = (q4[0] + q4[1]) + (q4[2] + q4[3]);
            const float rstd = rsqrtf(((tq[0] + tq[1]) + (tq[2] + tq[3])) * (1.0f / 1024.0f) + 1e-6f);
            float* o = p.out + (size_t)row * 1024;
#pragma unroll
            for (int jj = 0; jj < 4; ++jj) { const int n = 4 * lane + 256 * jj; f32x4 v = *(const f32x4*)(o + n); v = v * rstd * *(const f32x4*)(p.in[20] + n); *(f32x4*)(o + n) = v; }
        }
    }
}

extern "C" void kernel_launch(void* const* d_in, const int* in_sizes, int n_in, void* d_out, int out_size, void* d_ws, size_t ws_size, hipStream_t stream) {
    static int grid_blocks = 0;
    if (grid_blocks == 0) {
        if (n_in != 21 || ws_size < WS_END) { fprintf(stderr, "kernel_launch: need 21 inputs and >= %zu bytes of workspace; got %d, %zu\n", (size_t)WS_END, n_in, ws_size); grid_blocks = -1; return; }
        int dev = 0, cus = 0, per_cu = 0;
        hipGetDevice(&dev);
        hipDeviceGetAttribute(&cus, hipDeviceAttributeMultiprocessorCount, dev);
        if (hipFuncSetAttribute((const void*)mega, hipFuncAttributeMaxDynamicSharedMemorySize, LDS_BYTES) != hipSuccess) { fprintf(stderr, "kernel_launch: hipFuncSetAttribute failed\n"); }
        if (hipOccupancyMaxActiveBlocksPerMultiprocessor(&per_cu, (const void*)mega, 512, LDS_BYTES) != hipSuccess || per_cu < 1) { fprintf(stderr, "kernel_launch: occupancy query says %d\n", per_cu); per_cu = 1; }
        (void)hipGetLastError();
        grid_blocks = cus * 1;
        fprintf(stderr, "kernel_launch: cus %d per_cu %d grid %d ws %zu need %zu\n", cus, per_cu, grid_blocks, ws_size, (size_t)WS_END);
    }
    if (grid_blocks < 0) return;
    hipMemsetAsync(d_ws, 0, CTL_BYTES, stream);
    P p{};
    for (int i = 0; i < 21; ++i) p.in[i] = (const float*)d_in[i];
    p.out = (float*)d_out; p.ws = (unsigned char*)d_ws;
    void* args[] = {&p};
    hipError_t e = hipLaunchCooperativeKernel((const void*)mega, dim3(grid_blocks), dim3(512), args, LDS_BYTES, stream);
    if (e != hipSuccess) fprintf(stderr, "cooperative launch failed: %s (grid %d)\n", hipGetErrorString(e), grid_blocks);
}
```

```cpp
#include <hip/hip_runtime.h>
#include <hip/hip_cooperative_groups.h>
#include <cstdio>
namespace cg = cooperative_groups;

#define DI __device__ __forceinline__
#define LAS __attribute__((address_space(3)))
#define GAS __attribute__((address_space(1)))
typedef unsigned short bf16_t;
typedef short bf16x8 __attribute__((ext_vector_type(8)));
typedef float f32x2 __attribute__((ext_vector_type(2)));
typedef float f32x4 __attribute__((ext_vector_type(4)));
typedef float f32x16 __attribute__((ext_vector_type(16)));
typedef unsigned u32x2 __attribute__((ext_vector_type(2)));
typedef unsigned u32x4 __attribute__((ext_vector_type(4)));
typedef __bf16 bf2_t __attribute__((ext_vector_type(2)));

constexpr int NROWS = 17408, TPB = 4352;
constexpr float LOG2E = 1.4426950408889634f;
constexpr float QSCALE = 0.125f * LOG2E;

constexpr size_t al256(size_t x) { return (x + 255) & ~(size_t)255; }
constexpr size_t OFF_CTL = 0;
constexpr size_t OFF_ROWSQ = 256;
constexpr size_t OFF_BAR = al256(256 + 9 * (size_t)NROWS * 4);
constexpr size_t CTL_BYTES = al256(OFF_BAR + 3456 * 4);
constexpr size_t OFF_MOD = CTL_BYTES;
constexpr size_t OFF_SWMIX = OFF_MOD + 4 * 5 * 6144 * 4;
constexpr size_t OFF_SWMLP = OFF_SWMIX + 4 * 5 * 3072 * 4;
constexpr size_t OFF_LAM = OFF_SWMLP + 4 * 5 * 4096 * 4;
constexpr size_t OFF_ROPE = OFF_LAM + 256;
constexpr size_t OFF_XC = OFF_ROPE + 8192;
constexpr size_t OFF_XB = OFF_XC + 1024 * 1024 * 4;
constexpr size_t OFF_WINAB = OFF_XB + (size_t)NROWS * 1024 * 2;
constexpr size_t OFF_WOUTAB = OFF_WINAB + 2 * 2560 * 1024 * 2;
constexpr size_t OFF_WQKV = OFF_WOUTAB + 2 * 1024 * 1024 * 2;
constexpr size_t OFF_WOUTD = OFF_WQKV + 2 * 3072 * 1024 * 2;
constexpr size_t OFF_WMI = OFF_WOUTD + 2 * 1024 * 1024 * 2;
constexpr size_t OFF_WMO = OFF_WMI + 4ull * 4096 * 1024 * 2;
constexpr size_t OFF_TP = OFF_WMO + 4ull * 4096 * 1024 * 2;
constexpr size_t OFF_D128 = OFF_TP + 65536ull * 256 * 2;
constexpr size_t OFF_DFTC = OFF_D128 + 256 * 256 * 2;
constexpr size_t OFF_U = OFF_DFTC + 256 * 512 * 2;
constexpr size_t OFF_QK = OFF_U;
constexpr size_t OFF_FTL = OFF_QK + (size_t)NROWS * 1024 * 2;
constexpr size_t OFF_FTC = OFF_FTL + 2048ull * 8192 * 2;
constexpr size_t OFF_VT = OFF_QK + (size_t)NROWS * 2048 * 2;
constexpr size_t OFF_CAT = OFF_VT + (size_t)NROWS * 1024 * 2;
constexpr size_t OFF_R16 = OFF_U + (size_t)NROWS * 4096 * 2;
constexpr size_t OFF_RSQ16 = OFF_R16 + (size_t)NROWS * 1024 * 2;
constexpr size_t WS_END = OFF_RSQ16 + 9ull * NROWS * 16 * 4;
static_assert(OFF_CAT + (size_t)NROWS * 1024 * 2 == OFF_R16, "overlay");
static_assert(OFF_FTC + 2048ull * 512 * 2 == OFF_VT, "overlay2");
constexpr int LDS_BYTES = 131072 + 256;

struct P {
    const float* in[21];
    float* out;
    unsigned char* ws;
};

template <class T> DI T* as_global(T* p) { return (T*)(GAS T*)p; }
DI unsigned pk2(float a, float b) { bf2_t r = __builtin_convertvector((f32x2){a, b}, bf2_t); return __builtin_bit_cast(unsigned, r); }
DI bf16_t bf1(float a) { return (bf16_t)(pk2(a, 0.f) & 0xffffu); }
DI float wave_sum(float v) {
#pragma unroll
    for (int o = 1; o < 64; o <<= 1) v += __shfl_xor(v, o);
    return v;
}
DI int get_tid(int wave_s) { int lane; asm volatile("v_mbcnt_lo_u32_b32 %0, -1, 0\n\tv_mbcnt_hi_u32_b32 %0, -1, %0" : "=v"(lane)); return wave_s * 64 + lane; }
#define MFMA32(a, b, c) __builtin_amdgcn_mfma_f32_32x32x16_bf16((a), (b), (c), 0, 0, 0)

#define XB_TMO      128
#define XB_XCNT(j)  (256  + 64 * (j))
#define XB_XSUB(j)  (1280 + 64 * (j))
#define XB_XGEN(j)  (2304 + 64 * (j))
#define XB_TOP      3328
#define XB_TOPGEN   3392
#define XB_SPIN_CAP (1u << 20)
DI unsigned xb_ld(unsigned* p)              { return __hip_atomic_load(p, __ATOMIC_RELAXED, __HIP_MEMORY_SCOPE_AGENT); }
DI unsigned xb_add(unsigned* p, unsigned v) { return __hip_atomic_fetch_add(p, v, __ATOMIC_RELAXED, __HIP_MEMORY_SCOPE_AGENT); }
DI unsigned xb_xcc_id() { return (unsigned)__builtin_amdgcn_s_getreg((3 << 11) | 20) & 0xFu; }
#define XB_SPIN(cond, bar) do { unsigned _sp = 0; while (cond) { __builtin_amdgcn_s_sleep(1); \
    if ((++_sp & 255u) == 0u) { if (xb_ld(&(bar)[XB_TMO])) break; if (_sp > XB_SPIN_CAP) { atomicAdd(&(bar)[XB_TMO], 1u); break; } } } } while (0)
struct XcdBarrier { unsigned* bar; unsigned x; volatile LAS unsigned* st; };
DI XcdBarrier xcd_barrier_post(unsigned* bar, volatile LAS unsigned* st) {
    XcdBarrier b; b.bar = bar; b.x = xb_xcc_id(); b.st = st;
    if (threadIdx.x == 0) (void)xb_add(&bar[XB_XCNT(b.x)], 1u);
    return b;
}
DI void xcd_barrier_complete(unsigned* bar, unsigned x, unsigned& nloc, unsigned& nx) {
    const unsigned G = gridDim.x * gridDim.y * gridDim.z;
    unsigned sum, cnt, mine, sp = 0u;
    for (;;) {
        sum = 0u; cnt = 0u; mine = 0u;
#pragma unroll
        for (unsigned j = 0; j < 16; ++j) { const unsigned c = xb_ld(&bar[XB_XCNT(j)]); sum += c; cnt += (c > 0u) ? 1u : 0u; mine = (j == x) ? c : mine; }
        if (sum == G) break;
        __builtin_amdgcn_s_sleep(1);
        if ((++sp & 255u) == 0u) { if (xb_ld(&bar[XB_TMO])) break; if (sp > XB_SPIN_CAP) { atomicAdd(&bar[XB_TMO], 1u); break; } }
    }
    nloc = mine > 0u ? mine : 1u; nx = cnt > 0u ? cnt : 1u;
}
DI void xcd_barrier(const XcdBarrier& b, const int tid) {
    asm volatile("s_waitcnt vmcnt(0)" ::: "memory");
    __syncthreads();
    if (tid == 0) {
        unsigned* bar = b.bar;
        __builtin_amdgcn_s_waitcnt(0);
        unsigned nloc = b.st[0], nx = b.st[1];
        if (nloc == 0u) { xcd_barrier_complete(bar, b.x, nloc, nx); b.st[0] = nloc; b.st[1] = nx; }
        const unsigned old = xb_add(&bar[XB_XSUB(b.x)], 1u);
        const unsigned gen = old / nloc;
        if (old + 1u == (gen + 1u) * nloc) {
            __builtin_amdgcn_fence(__ATOMIC_RELEASE, "agent");
            asm volatile("s_waitcnt vmcnt(0)" ::: "memory");
            const unsigned og = xb_add(&bar[XB_TOP], 1u);
            const unsigned tg = og / nx;
            if (og + 1u == (tg + 1u) * nx) xb_add(&bar[XB_TOPGEN], 1u);
            else XB_SPIN(xb_ld(&bar[XB_TOPGEN]) == tg, bar);
            __builtin_amdgcn_fence(__ATOMIC_ACQUIRE, "agent");
            xb_add(&bar[XB_XGEN(b.x)], 1u);
            asm volatile("s_waitcnt vmcnt(0)" ::: "memory");
        } else {
            XB_SPIN(xb_ld(&bar[XB_XGEN(b.x)]) == gen, bar);
            __builtin_amdgcn_fence(__ATOMIC_ACQUIRE, "agent");
            asm volatile("s_waitcnt vmcnt(0)" ::: "memory");
        }
    }
    __syncthreads();
}

namespace pg8 {
constexpr int BM = 256, BK = 64, HALF = 128, HTB = HALF * BK * 2, STAGE_BYTES = 8 * HTB, NXCD = 8, WGM = 8;
DI int lds_byte(int r, int c) { const int st = (r >> 4) * 2 + (c >> 5), rr = r & 15, cc = c & 31, ob = rr * 64 + cc * 2; return st * 1024 + (ob ^ (((ob >> 9) & 1) << 5)); }
DI void stage_rc(int b, int& R, int& C) { const int st = b / 1024, sb = b % 1024, swz = sb ^ (((sb >> 9) & 1) << 5); R = (st >> 1) * 16 + swz / 64; C = (st & 1) * 32 + (swz % 64) / 2; }
DI int perm32(int rho) { const int n = rho >> 4, i = rho & 15; return 8 * (i >> 2) + 4 * n + (i & 3); }
struct Unit { int pm, pn; };
struct Gemm { const bf16_t* A; const bf16_t* Bt; int M, N, K; };
struct StaticOrder {
    int nM, nN, nwg, G, c, skip;
    DI void init(int M, int N, int G_, int c_, int skip_) { nM = M / BM; nN = N / BM; nwg = nM * nN; G = G_; c = c_; skip = skip_; }
    DI bool next(int i, Unit& u) const {
        const long L = (long)i * G + c; if (L >= nwg) return false;
        int wgid = (int)L; { const int q = nwg / NXCD, r = nwg % NXCD, xcd = wgid % NXCD, off = wgid / NXCD; wgid = (xcd < r ? xcd * (q + 1) : r * (q + 1) + (xcd - r) * q) + off; }
        const int nig = WGM * nN, gid = wgid / nig, fm = gid * WGM, gsz = (nM - fm) < WGM ? (nM - fm) : WGM;
        u.pm = fm + ((wgid % nig) % gsz); u.pn = (wgid % nig) / gsz; if (skip) u.pm += (u.pm >> 4) + 1; return true;
    }
};

template <class Epi>
DI void gemm_phase(LAS unsigned char* lds, const Gemm g, const StaticOrder& S, const Epi& E, const int tid) {
    const int wid = __builtin_amdgcn_readfirstlane(tid >> 6), lane = tid & 63, wr = wid >> 2, wc = wid & 3, fr = lane & 15, fq = lane >> 4;
    const int K = g.K, nt = K / BK;
    unsigned voffA[2], voffB[2];
#pragma unroll
    for (int i = 0; i < 2; ++i) { int R, C; stage_rc(tid * 16 + i * 8192, R, C); const int Rb = E.perm ? ((R & ~31) + perm32(R & 31)) : R;
        voffA[i] = (unsigned)(R * K + C) * 2u; voffB[i] = (unsigned)(Rb * K + C) * 2u; }
    const size_t kstep = (size_t)(BK * 2);
    const size_t hstep = (size_t)HALF * K * 2;
    const size_t tstep = 2 * hstep;
    const unsigned ldsw = (unsigned)wid * 1024u;
    const int aoff = lds_byte(wr * 64 + fr, fq * 8), boff = lds_byte(wc * 32 + fr, fq * 8);
#define PG8_SA(b, h) (((b) * 2 + (h)) * HTB)
#define PG8_SB(b, h) ((4 + (b) * 2 + (h)) * HTB)
#define PG8_STAGE(bufoff, gbase, voff) do { _Pragma("unroll") for (int _i = 0; _i < 2; ++_i) \
        __builtin_amdgcn_global_load_lds((const unsigned*)((const char*)(gbase) + (voff)[_i]), (LAS unsigned*)(lds + (bufoff) + ldsw + _i * 8192), 16, 0, 0); } while (0)
#define PG8_LDA(dst, b, h) do { _Pragma("unroll") for (int m = 0; m < 4; ++m) _Pragma("unroll") for (int k = 0; k < 2; ++k) dst[m][k] = *(const LAS bf16x8*)(lds + PG8_SA(b, h) + aoff + m * 2048 + k * 1024); } while (0)
#define PG8_LDB(dst, b, h) do { _Pragma("unroll") for (int n = 0; n < 2; ++n) _Pragma("unroll") for (int k = 0; k < 2; ++k) dst[n][k] = *(const LAS bf16x8*)(lds + PG8_SB(b, h) + boff + n * 2048 + k * 1024); } while (0)
#define PG8_MMA(ai, bj, At, Bt) do { __builtin_amdgcn_s_setprio(1); _Pragma("unroll") for (int m = 0; m < 4; ++m) _Pragma("unroll") for (int n = 0; n < 2; ++n) _Pragma("unroll") for (int k = 0; k < 2; ++k) \
        acc[ai][bj][m][n] = __builtin_amdgcn_mfma_f32_16x16x32_bf16(Bt[n][k], At[m][k], acc[ai][bj][m][n], 0, 0, 0); __builtin_amdgcn_s_setprio(0); } while (0)
#define PG8_WAIT_V(n) asm volatile("s_waitcnt vmcnt(" #n ")" ::: "memory")
#define PG8_WAIT_L(n) asm volatile("s_waitcnt lgkmcnt(" #n ")" ::: "memory")
#define PG8_BAR __builtin_amdgcn_s_barrier()
#define PG8_SCHED __builtin_amdgcn_sched_barrier(0)
    Unit cur, nxt; int ui = 0;
    if (!S.next(0, cur)) return;
    f32x4 acc[2][2][4][2];
#pragma unroll
    for (int a = 0; a < 2; ++a)
#pragma unroll
        for (int b = 0; b < 2; ++b)
#pragma unroll
            for (int m = 0; m < 4; ++m)
#pragma unroll
                for (int n = 0; n < 2; ++n) acc[a][b][m][n] = (f32x4){0.f, 0.f, 0.f, 0.f};
    bf16x8 At[4][2], B0[2][2], B1[2][2];
    const char* cA = (const char*)g.A + (size_t)cur.pm * tstep; const char* cB = (const char*)g.Bt + (size_t)cur.pn * tstep;
    PG8_STAGE(PG8_SB(0, 0), cB, voffB); PG8_STAGE(PG8_SA(0, 0), cA, voffA); PG8_STAGE(PG8_SB(0, 1), cB + hstep, voffB); PG8_STAGE(PG8_SA(0, 1), cA + hstep, voffA);
    if (wr == 1) PG8_BAR;
    PG8_WAIT_V(4); PG8_BAR;
    PG8_STAGE(PG8_SB(1, 0), cB + kstep, voffB); PG8_STAGE(PG8_SA(1, 0), cA + kstep, voffA); PG8_STAGE(PG8_SB(1, 1), cB + hstep + kstep, voffB);
    PG8_WAIT_V(6); PG8_BAR;
    for (;;) {
        const bool has_next = S.next(ui + 1, nxt);
        const char* nA = has_next ? (const char*)g.A + (size_t)nxt.pm * tstep : cA; const char* nB = has_next ? (const char*)g.Bt + (size_t)nxt.pn * tstep : cB;
        for (int t = 0; t < nt; t += 2) {
            const bool last = (t == nt - 2);
            const char* a1 = cA + (size_t)(t + 1) * kstep;
            const char* a2 = last ? nA : cA + (size_t)(t + 2) * kstep; const char* b2 = last ? nB : cB + (size_t)(t + 2) * kstep;
            const char* a3 = a2 + kstep; const char* b3 = b2 + kstep;
            PG8_LDB(B0, 0, 0); PG8_SCHED; PG8_LDA(At, 0, 0); PG8_STAGE(PG8_SA(1, 1), a1 + hstep, voffA);
            PG8_WAIT_L(8); PG8_BAR; PG8_WAIT_L(0); PG8_MMA(0, 0, At, B0); PG8_BAR; PG8_SCHED;
            PG8_LDB(B1, 0, 1); PG8_STAGE(PG8_SB(0, 0), b2, voffB);
            PG8_BAR; PG8_WAIT_L(0); PG8_MMA(0, 1, At, B1); PG8_BAR;
            PG8_LDA(At, 0, 1); PG8_STAGE(PG8_SA(0, 0), a2, voffA);
            PG8_BAR; PG8_WAIT_L(0); PG8_MMA(1, 0, At, B0); PG8_BAR; PG8_SCHED;
            PG8_STAGE(PG8_SB(0, 1), b2 + hstep, voffB);
            PG8_WAIT_V(6); PG8_BAR; PG8_MMA(1, 1, At, B1); PG8_BAR;
            PG8_LDB(B0, 1, 0); PG8_SCHED; PG8_LDA(At, 1, 0); PG8_STAGE(PG8_SA(0, 1), a2 + hstep, voffA);
            PG8_WAIT_L(8); PG8_BAR; PG8_WAIT_L(0); PG8_MMA(0, 0, At, B0); PG8_BAR; PG8_SCHED;
            PG8_LDB(B1, 1, 1); PG8_STAGE(PG8_SB(1, 0), b3, voffB);
            PG8_BAR; PG8_WAIT_L(0); PG8_MMA(0, 1, At, B1); PG8_BAR;
            PG8_LDA(At, 1, 1); PG8_STAGE(PG8_SA(1, 0), a3, voffA);
            PG8_BAR; PG8_WAIT_L(0); PG8_MMA(1, 0, At, B0); PG8_BAR; PG8_SCHED;
            PG8_STAGE(PG8_SB(1, 1), b3 + hstep, voffB);
            PG8_WAIT_V(6); PG8_BAR; PG8_MMA(1, 1, At, B1); PG8_BAR;
        }
        { int t2 = tid; asm volatile("" : "+v"(t2)); const int w2 = __builtin_amdgcn_readfirstlane(t2 >> 6), l2 = t2 & 63; E(acc, cur, w2 >> 2, w2 & 3, l2 & 15, l2 >> 4); }
        if (!has_next) break;
#pragma unroll
        for (int a = 0; a < 2; ++a)
#pragma unroll
            for (int b = 0; b < 2; ++b)
#pragma unroll
                for (int m = 0; m < 4; ++m)
#pragma unroll
                    for (int n = 0; n < 2; ++n) acc[a][b][m][n] = (f32x4){0.f, 0.f, 0.f, 0.f};
        cur = nxt; cA = nA; cB = nB; ++ui;
    }
    PG8_WAIT_V(0);
    if (wr == 0) PG8_BAR;
    PG8_BAR;
#undef PG8_SA
#undef PG8_SB
#undef PG8_STAGE
#undef PG8_LDA
#undef PG8_LDB
#undef PG8_MMA
#undef PG8_WAIT_V
#undef PG8_WAIT_L
#undef PG8_BAR
#undef PG8_SCHED
}
}

DI int perm_pos(int t) { return (t & ~12) | ((t & 4) << 1) | ((t & 8) >> 1); }
struct Epi {
    int mode;
    int perm, l, s;
    unsigned char* wsp; float* outp; const float* in0; const float* in2; const float* in6; const float* in7;
};
struct ColVec { f32x4 a0, a1, b0, b1; };
DI ColVec load_colvec(const Epi& E, unsigned char* ws, int l_, int bsel, int c0) {
    ColVec cv;
    if (E.mode <= 2) {
        const int nsw = (E.mode == 2) ? 4096 : 3072;
        const float* sw = (E.mode == 2) ? (const float*)(ws + OFF_SWMLP) + (size_t)l_ * 5 * 4096 : (const float*)(ws + OFF_SWMIX) + (size_t)l_ * 5 * 3072;
        const float* q = sw + (size_t)bsel * nsw + c0;
        cv.a0 = *(const f32x4*)q; cv.a1 = *(const f32x4*)(q + 4); cv.b0 = cv.a0; cv.b1 = cv.a1;
    } else {
        const float* MOD = (const float*)(ws + OFF_MOD);
        const bool first = (E.s == 2);
        const float* gate = MOD + (size_t)l_ * 5 * 6144 + (first ? 2 : 5) * 1024 + (size_t)bsel * 6144 + c0;
        cv.a0 = *(const f32x4*)gate; cv.a1 = *(const f32x4*)(gate + 4);
        const float* gnext = first ? E.in7 + l_ * 1024 : (l_ < 3 ? E.in6 + (l_ + 1) * 1024 : nullptr);
        if (gnext) { const float* sc = (first ? MOD + (size_t)l_ * 5 * 6144 + 4 * 1024 : MOD + (size_t)(l_ + 1) * 5 * 6144 + 1024) + (size_t)bsel * 6144 + c0;
            cv.b0 = *(const f32x4*)(gnext + c0) * (*(const f32x4*)sc + 1.0f); cv.b1 = *(const f32x4*)(gnext + c0 + 4) * (*(const f32x4*)(sc + 4) + 1.0f); }
        else { cv.b0 = (f32x4){0.f, 0.f, 0.f, 0.f}; cv.b1 = cv.b0; }
    }
    return cv;
}
DI float row_rstd(const Epi& E, unsigned char* ws, int l_, int row) {
    const f32x4* q = (const f32x4*)((const float*)(ws + OFF_RSQ16) + ((size_t)(2 * l_ + (E.mode == 2 ? 1 : 0)) * NROWS + row) * 16);
    const f32x4 a = q[0], b_ = q[1], c = q[2], d = q[3];
    const f32x4 t = (a + b_) + (c + d);
    return rsqrtf(((t[0] + t[1]) + (t[2] + t[3])) * (1.0f / 1024.0f) + 1e-6f);
}
DI float emit8(const Epi& E, unsigned char* ws, int l_, int row, int b, int tall, bool isctx, int c0, float (&v)[8], const ColVec& cv, float rstd) {
    if (E.mode <= 2) {
#pragma unroll
        for (int i = 0; i < 4; ++i) { v[i] = v[i] * rstd + cv.a0[i]; v[4 + i] = v[4 + i] * rstd + cv.a1[i]; }
        if (E.mode == 2) {
            bf16_t* ob = (bf16_t*)(ws + OFF_U);
#pragma unroll
            for (int i = 0; i < 8; ++i) { const float r = fmaxf(v[i], 0.f); v[i] = r * r; }
            u32x4 w; w.x = pk2(v[0], v[1]); w.y = pk2(v[2], v[3]); w.z = pk2(v[4], v[5]); w.w = pk2(v[6], v[7]);
            *(u32x4*)(ob + (size_t)row * 4096 + c0) = w;
        } else if (E.mode == 0) {
            if (c0 < 1024) {
                const int cs = c0 >> 9; const int gc0 = (c0 & 511);
                if (isctx) { bf16_t* d = (bf16_t*)(ws + OFF_FTC) + ((size_t)(b * 512 + gc0) * 2 + cs) * 256 + tall;
#pragma unroll
                    for (int i = 0; i < 8; ++i) d[(size_t)i * 512] = bf1(v[i]);
                } else { bf16_t* d = (bf16_t*)(ws + OFF_FTL) + ((size_t)(b * 512 + gc0) * 2 + cs) * 4096 + (tall - 256);
#pragma unroll
                    for (int i = 0; i < 8; ++i) d[(size_t)i * 8192] = bf1(v[i]); }
            } else if (c0 < 2048) {
                const float sc = (c0 < 1536) ? QSCALE : 1.0f;
                u32x4 w; w.x = pk2(v[0] * sc, v[1] * sc); w.y = pk2(v[2] * sc, v[3] * sc); w.z = pk2(v[4] * sc, v[5] * sc); w.w = pk2(v[6] * sc, v[7] * sc);
                *(u32x4*)((bf16_t*)(ws + OFF_QK) + (size_t)row * 1024 + (c0 - 1024)) = w;
            } else {
                const int cv_ = c0 - 2048; const int h = cv_ >> 6, d0 = cv_ & 63;
                bf16_t* d = (bf16_t*)(ws + OFF_VT) + ((size_t)((b * 8 + h) * 64 + d0)) * TPB + perm_pos(tall);
#pragma unroll
                for (int i = 0; i < 8; ++i) d[(size_t)i * TPB] = bf1(v[i]);
            }
        } else {
            if (c0 < 2048) {
                if (!isctx) {
                    const int t = tall - 256; const int pos = ((c0 >> 5) & 1) ? (t & 63) : (t >> 6);
                    const float* rp = (const float*)(ws + OFF_ROPE) + (size_t)(pos * 16 + (c0 & 8)) * 2;
                    const bool hi2 = ((c0 >> 4) & 1) != 0;
#pragma unroll
                    for (int i = 0; i < 8; ++i) { const float pv = __shfl_xor(v[i], 32); const float cs_ = rp[2 * i], sn = rp[2 * i + 1];
                        v[i] = hi2 ? (pv * sn + v[i] * cs_) : (v[i] * cs_ - pv * sn); }
                }
                const float sc = (c0 < 1024) ? QSCALE : 1.0f;
                u32x4 w; w.x = pk2(v[0] * sc, v[1] * sc); w.y = pk2(v[2] * sc, v[3] * sc); w.z = pk2(v[4] * sc, v[5] * sc); w.w = pk2(v[6] * sc, v[7] * sc);
                *(u32x4*)((bf16_t*)(ws + OFF_QK) + (size_t)row * 2048 + c0) = w;
            } else {
                const int cv_ = c0 - 2048; const int h = cv_ >> 7, d0 = cv_ & 127;
                bf16_t* d = (bf16_t*)(ws + OFF_VT) + ((size_t)((b * 8 + h) * 128 + d0)) * TPB + perm_pos(tall);
#pragma unroll
                for (int i = 0; i < 8; ++i) d[(size_t)i * TPB] = bf1(v[i]);
            }
        }
        return 0.f;
    } else {
        const bool l0 = (E.s == 2) && l_ == 0;
        const bool lastw = (E.s == 4) && l_ == 3;
        f32x4 r0, r1;
        if (l0) { const size_t rloc = isctx ? (size_t)(b * 256 + tall) : (size_t)(b * 4096 + tall - 256);
            const float* rp = (isctx ? E.in2 : E.in0) + rloc * 1024 + c0; r0 = *(const f32x4*)rp; r1 = *(const f32x4*)(rp + 4); }
        else { const u32x4 rw = *(const u32x4*)((const bf16_t*)(ws + OFF_R16) + (size_t)row * 1024 + c0);
            r0 = (f32x4){__uint_as_float(rw.x << 16), __uint_as_float(rw.x & 0xffff0000u), __uint_as_float(rw.y << 16), __uint_as_float(rw.y & 0xffff0000u)};
            r1 = (f32x4){__uint_as_float(rw.z << 16), __uint_as_float(rw.z & 0xffff0000u), __uint_as_float(rw.w << 16), __uint_as_float(rw.w & 0xffff0000u)}; }
        const f32x4 x0 = r0 + cv.a0 * (f32x4){v[0], v[1], v[2], v[3]};
        const f32x4 x1 = r1 + cv.a1 * (f32x4){v[4], v[5], v[6], v[7]};
        if (lastw) { float* op = E.outp + (size_t)(b * 4096 + tall - 256) * 1024 + c0; *(f32x4*)op = x0; *(f32x4*)(op + 4) = x1; }
        else { u32x4 w; w.x = pk2(x0[0], x0[1]); w.y = pk2(x0[2], x0[3]); w.z = pk2(x1[0], x1[1]); w.w = pk2(x1[2], x1[3]);
            *(u32x4*)((bf16_t*)(ws + OFF_R16) + (size_t)row * 1024 + c0) = w; }
        const bool has_next = (E.s == 2) || l_ < 3;
        if (has_next) { const f32x4 y0 = x0 * cv.b0, y1 = x1 * cv.b1; u32x4 w; w.x = pk2(y0[0], y0[1]); w.y = pk2(y0[2], y0[3]); w.z = pk2(y1[0], y1[1]); w.w = pk2(y1[2], y1[3]);
            *(u32x4*)((bf16_t*)(ws + OFF_XB) + (size_t)row * 1024 + c0) = w; }
        return ((x0[0] * x0[0] + x0[1] * x0[1]) + (x0[2] * x0[2] + x0[3] * x0[3])) + ((x1[0] * x1[0] + x1[1] * x1[1]) + (x1[2] * x1[2] + x1[3] * x1[3]));
    }
}
DI float* rowsq_out_ptr(const Epi& E, unsigned char* ws, int l_) { return (float*)(ws + OFF_RSQ16) + (size_t)(2 * l_ + (E.s == 2 ? 1 : 2)) * NROWS * 16; }

struct EpiPg8 {
    Epi E; int perm;
    DI void operator()(const f32x4 (&acc)[2][2][4][2], const pg8::Unit& u, int wr, int wc, int fr, int fq) const {
        unsigned z_ = 0u; int l_ = E.l; asm volatile("" : "+s"(z_), "+s"(l_)); unsigned char* ws = E.wsp + z_;
        if (E.mode <= 2) {
            const int b = u.pm / 17, tp = u.pm % 17; const bool isctx = (tp == 0); const int bsel = isctx ? 4 : b;
            const int colt = u.pn * 256 + wc * 32 + 8 * fq;
            ColVec cv[2];
#pragma unroll
            for (int bj = 0; bj < 2; ++bj) cv[bj] = load_colvec(E, ws, l_, bsel, colt + 128 * bj);
#pragma unroll
            for (int ai = 0; ai < 2; ++ai)
#pragma unroll
                for (int m = 0; m < 4; ++m) {
                    const int rl = ai * 128 + wr * 64 + m * 16 + fr; const int row = u.pm * 256 + rl; const int tall = tp * 256 + rl;
                    const float rstd = row_rstd(E, ws, l_, row);
#pragma unroll
                    for (int bj = 0; bj < 2; ++bj) {
                        float v[8];
#pragma unroll
                        for (int i = 0; i < 4; ++i) { v[i] = acc[ai][bj][m][0][i]; v[4 + i] = acc[ai][bj][m][1][i]; }
                        (void)emit8(E, ws, l_, row, b, tall, isctx, colt + 128 * bj, v, cv[bj], rstd);
                    }
                }
        } else if (E.mode == 3) {
            const int b = u.pm / 17, tp = u.pm % 17; const bool isctx = (tp == 0); const int bsel = isctx ? 4 : b;
            const int colt = u.pn * 256 + wc * 32 + 8 * fq;
            ColVec cv[2];
#pragma unroll
            for (int bj = 0; bj < 2; ++bj) cv[bj] = load_colvec(E, ws, l_, bsel, colt + 128 * bj);
            float* rso = rowsq_out_ptr(E, ws, l_);
#pragma unroll
            for (int ai = 0; ai < 2; ++ai)
#pragma unroll
                for (int m = 0; m < 4; ++m) {
                    const int rl = ai * 128 + wr * 64 + m * 16 + fr; const int row = u.pm * 256 + rl; const int tall = tp * 256 + rl;
                    float ss = 0.f;
#pragma unroll
                    for (int bj = 0; bj < 2; ++bj) {
                        float v[8];
#pragma unroll
                        for (int i = 0; i < 4; ++i) { v[i] = acc[ai][bj][m][0][i]; v[4 + i] = acc[ai][bj][m][1][i]; }
                        ss += emit8(E, ws, l_, row, b, tall, isctx, colt + 128 * bj, v, cv[bj], 0.f);
                    }
                    ss += __shfl_xor(ss, 16); ss += __shfl_xor(ss, 32);
                    if (fq == 0) rso[(size_t)row * 16 + u.pn * 4 + wc] = ss;
                }
        } else if (E.mode == 4) {
            bf16_t* ob = (bf16_t*)(ws + OFF_CAT);
            const float alpha = 0.0013810679320049757f;
#pragma unroll
            for (int ai = 0; ai < 2; ++ai)
#pragma unroll
                for (int m = 0; m < 4; ++m) {
                    const int R = u.pm * 256 + ai * 128 + wr * 64 + m * 16 + fr;
                    const int b = R >> 14, k1 = (R >> 9) & 31, gc = R & 511;
                    const int k2 = wc * 32 + 8 * fq;
                    bf16_t* d = ob + (size_t)(b * TPB + 256 + k1 + 32 * k2) * 1024 + gc;
#pragma unroll
                    for (int i = 0; i < 4; ++i) { d[(size_t)i * 32 * 1024] = bf1(acc[ai][0][m][0][i] * alpha); d[(size_t)(4 + i) * 32 * 1024] = bf1(acc[ai][0][m][1][i] * alpha); }
                }
        } else {
            bf16_t* ob = (bf16_t*)(ws + OFF_CAT);
            const float alpha = 0.005524271728019903f;
            const int nrow0 = u.pn * 256 + wc * 32 + 8 * fq;
#pragma unroll
            for (int ai = 0; ai < 2; ++ai)
#pragma unroll
                for (int m = 0; m < 4; ++m) {
                    const int k = u.pm * 256 + ai * 128 + wr * 64 + m * 16 + fr;
#pragma unroll
                    for (int bj = 0; bj < 2; ++bj) { const int nr = nrow0 + 128 * bj; const int b = nr >> 9, gc = nr & 511;
                        const f32x4 a0 = acc[ai][bj][m][0] * alpha, a1 = acc[ai][bj][m][1] * alpha;
                        u32x4 w; w.x = pk2(a0[0], a0[1]); w.y = pk2(a0[2], a0[3]); w.z = pk2(a1[0], a1[1]); w.w = pk2(a1[2], a1[3]);
                        *(u32x4*)(ob + (size_t)(b * TPB + k) * 1024 + gc) = w; }
                }
        }
    }
};

constexpr int bitrev5(int x) { return ((x & 1) << 4) | ((x & 2) << 2) | (x & 4) | ((x & 8) >> 2) | ((x & 16) >> 4); }
DI float bf2f(bf16_t v) { return __uint_as_float(((unsigned)v) << 16); }
DI void fft_stage1_item(unsigned char* ws, int item, int tid) {
    constexpr float FC[16] = {1.0f, 0.98078528040323043f, 0.92387953251128674f, 0.83146961230254524f, 0.70710678118654752f, 0.55557023301960218f, 0.38268343236508977f, 0.19509032201612825f,
                              0.0f, -0.19509032201612825f, -0.38268343236508977f, -0.55557023301960218f, -0.70710678118654752f, -0.83146961230254524f, -0.92387953251128674f, -0.98078528040323043f};
    constexpr float FS[16] = {0.0f, 0.19509032201612825f, 0.38268343236508977f, 0.55557023301960218f, 0.70710678118654752f, 0.83146961230254524f, 0.92387953251128674f, 0.98078528040323043f,
                              1.0f, 0.98078528040323043f, 0.92387953251128674f, 0.83146961230254524f, 0.70710678118654752f, 0.55557023301960218f, 0.38268343236508977f, 0.19509032201612825f};
    const int nrow = item * 4 + (tid >> 7), n2 = tid & 127;
    const bf16_t* src = (const bf16_t*)(ws + OFF_FTL) + (size_t)nrow * 8192 + n2;
    float ar[32], ai[32];
#pragma unroll
    for (int n1 = 0; n1 < 32; ++n1) { ar[bitrev5(n1)] = bf2f(src[128 * n1]); ai[bitrev5(n1)] = -bf2f(src[4096 + 128 * n1]); }
#pragma unroll
    for (int st = 1; st <= 5; ++st) {
        const int m = 1 << st, h = m >> 1;
#pragma unroll
        for (int k = 0; k < 32; k += m)
#pragma unroll
            for (int jj = 0; jj < h; ++jj) {
                const int idx = jj * (32 / m);
                const float wr_ = FC[idx], wi_ = -FS[idx];
                const float xr = ar[k + jj + h], xi = ai[k + jj + h];
                const float tr = wr_ * xr - wi_ * xi, ti = wr_ * xi + wi_ * xr;
                const float ur = ar[k + jj], ui = ai[k + jj];
                ar[k + jj] = ur + tr; ai[k + jj] = ui + ti; ar[k + jj + h] = ur - tr; ai[k + jj + h] = ui - ti;
            }
    }
    const int b = nrow >> 9, gc = nrow & 511;
    bf16_t* dst = (bf16_t*)(ws + OFF_TP) + ((size_t)(b * 32) * 512 + gc) * 256 + n2;
#pragma unroll
    for (int k1 = 0; k1 < 32; ++k1) {
        const float rev = (float)(n2 * k1) * (1.0f / 4096.0f);
        const float c = __builtin_amdgcn_cosf(rev), sn = __builtin_amdgcn_sinf(rev);
        const float re = ar[k1] * c + ai[k1] * sn, im = ai[k1] * c - ar[k1] * sn;
        dst[(size_t)k1 * 512 * 256] = bf1(re); dst[(size_t)k1 * 512 * 256 + 128] = bf1(im);
    }
}

DI int mini_perm(int p) { const int q = p & 255, xcd = q & 7, idx = q >> 3; return (p & ~255) + ((((idx >> 4) + 2 * xcd) & 15) << 4) + (idx & 15); }
DI void mini_gemm_tile(const Epi& E, const bf16_t* A, const bf16_t* Bt, int K, int mt_lin, unsigned char* shm, int tid) {
    const int mt = mini_perm(mt_lin);
    const int rt = mt & 15, ct = mt >> 4;
    const int wv = tid >> 6, lane = tid & 63, l31 = lane & 31, hi = lane >> 5;
    const int ksl = K >> 3, kbeg = wv * ksl;
    const bf16_t* ap[2]; const bf16_t* bp[2];
#pragma unroll
    for (int mi = 0; mi < 2; ++mi) { const int r = rt * 64 + 32 * mi + l31; const int grow = (r >> 8) * TPB + (r & 255); ap[mi] = A + (size_t)grow * K + kbeg + 8 * hi; }
#pragma unroll
    for (int ni = 0; ni < 2; ++ni) bp[ni] = Bt + (size_t)(ct * 64 + 32 * ni + l31) * K + kbeg + 8 * hi;
    f32x16 acc[2][2];
#pragma unroll
    for (int mi = 0; mi < 2; ++mi)
#pragma unroll
        for (int ni = 0; ni < 2; ++ni)
#pragma unroll
            for (int i = 0; i < 16; ++i) acc[mi][ni][i] = 0.f;
    for (int k0 = 0; k0 < ksl; k0 += 128) {
        bf16x8 fa[8][2], fb[8][2];
#pragma unroll
        for (int q = 0; q < 8; ++q) { fa[q][0] = *(const bf16x8*)(ap[0] + k0 + 16 * q); fa[q][1] = *(const bf16x8*)(ap[1] + k0 + 16 * q); fb[q][0] = *(const bf16x8*)(bp[0] + k0 + 16 * q); fb[q][1] = *(const bf16x8*)(bp[1] + k0 + 16 * q); }
#pragma unroll
        for (int q = 0; q < 8; ++q) { acc[0][0] = MFMA32(fa[q][0], fb[q][0], acc[0][0]); acc[0][1] = MFMA32(fa[q][0], fb[q][1], acc[0][1]); acc[1][0] = MFMA32(fa[q][1], fb[q][0], acc[1][0]); acc[1][1] = MFMA32(fa[q][1], fb[q][1], acc[1][1]); }
    }
    float* red = (float*)shm + wv * 4096;
#pragma unroll
    for (int mi = 0; mi < 2; ++mi)
#pragma unroll
        for (int ni = 0; ni < 2; ++ni)
#pragma unroll
            for (int i = 0; i < 16; ++i) red[(32 * mi + (i & 3) + 8 * (i >> 2) + 4 * hi) * 64 + 32 * ni + l31] = acc[mi][ni][i];
    __syncthreads();
    {
        const int r = tid >> 3, cg = tid & 7;
        const float* src = (const float*)shm + r * 64 + cg * 8;
        f32x4 s0 = *(const f32x4*)src, s1 = *(const f32x4*)(src + 4);
#pragma unroll
        for (int w = 1; w < 8; ++w) { s0 += *(const f32x4*)(src + w * 4096); s1 += *(const f32x4*)(src + w * 4096 + 4); }
        float v[8] = {s0[0], s0[1], s0[2], s0[3], s1[0], s1[1], s1[2], s1[3]};
        const int cr = rt * 64 + r; const int b = cr >> 8, tall = cr & 255; const int row = b * TPB + tall; const int c0 = ct * 64 + cg * 8;
        const ColVec cv = load_colvec(E, E.wsp, E.l, 4, c0);
        const float rstd = (E.mode <= 2) ? row_rstd(E, E.wsp, E.l, row) : 0.f;
        float ss = emit8(E, E.wsp, E.l, row, b, tall, true, c0, v, cv, rstd);
        if (E.mode == 3) { ss += __shfl_xor(ss, 1); ss += __shfl_xor(ss, 2); ss += __shfl_xor(ss, 4);
            if (cg == 0) rowsq_out_ptr(E, E.wsp, E.l)[(size_t)row * 16 + ct] = ss; }
    }
    __syncthreads();
}

DI void mini_gemm_seq1024(const Epi& E, const bf16_t* A, const bf16_t* Bt, int mt0, int nmt, int G, unsigned char* shm, int tid) {
    if (mt0 >= nmt) return;
    constexpr int K = 1024;
    const int wv = tid >> 6, lane = tid & 63, l31 = lane & 31, hi = lane >> 5;
    const int kbeg = wv * 128;
    bf16x8 fa[8][2], fb[8][2];
#define MINI_LOAD(mt_) do { const int pm_ = mini_perm(mt_); const int rt_ = pm_ & 15, ct_ = pm_ >> 4; \
        _Pragma("unroll") for (int mi = 0; mi < 2; ++mi) { const int r_ = rt_ * 64 + 32 * mi + l31; const bf16_t* ap_ = A + (size_t)((r_ >> 8) * TPB + (r_ & 255)) * K + kbeg + 8 * hi; \
            _Pragma("unroll") for (int q = 0; q < 8; ++q) fa[q][mi] = *(const bf16x8*)(ap_ + 16 * q); } \
        _Pragma("unroll") for (int ni = 0; ni < 2; ++ni) { const bf16_t* bp_ = Bt + (size_t)(ct_ * 64 + 32 * ni + l31) * K + kbeg + 8 * hi; \
            _Pragma("unroll") for (int q = 0; q < 8; ++q) fb[q][ni] = *(const bf16x8*)(bp_ + 16 * q); } } while (0)
    MINI_LOAD(mt0);
    for (int mt = mt0; mt < nmt; mt += G) {
        const int pmt = mini_perm(mt); const int rt = pmt & 15, ct = pmt >> 4;
        f32x16 acc[2][2];
#pragma unroll
        for (int mi = 0; mi < 2; ++mi)
#pragma unroll
            for (int ni = 0; ni < 2; ++ni)
#pragma unroll
                for (int i = 0; i < 16; ++i) acc[mi][ni][i] = 0.f;
#pragma unroll
        for (int q = 0; q < 8; ++q) { acc[0][0] = MFMA32(fa[q][0], fb[q][0], acc[0][0]); acc[0][1] = MFMA32(fa[q][0], fb[q][1], acc[0][1]); acc[1][0] = MFMA32(fa[q][1], fb[q][0], acc[1][0]); acc[1][1] = MFMA32(fa[q][1], fb[q][1], acc[1][1]); }
        float* red = (float*)shm + wv * 4096;
#pragma unroll
        for (int mi = 0; mi < 2; ++mi)
#pragma unroll
            for (int ni = 0; ni < 2; ++ni)
#pragma unroll
                for (int i = 0; i < 16; ++i) red[(32 * mi + (i & 3) + 8 * (i >> 2) + 4 * hi) * 64 + 32 * ni + l31] = acc[mi][ni][i];
        if (mt + G < nmt) MINI_LOAD(mt + G);
        __syncthreads();
        {
            const int r = tid >> 3, cg = tid & 7;
            const float* src = (const float*)shm + r * 64 + cg * 8;
            f32x4 s0 = *(const f32x4*)src, s1 = *(const f32x4*)(src + 4);
#pragma unroll
            for (int w = 1; w < 8; ++w) { s0 += *(const f32x4*)(src + w * 4096); s1 += *(const f32x4*)(src + w * 4096 + 4); }
            float v[8] = {s0[0], s0[1], s0[2], s0[3], s1[0], s1[1], s1[2], s1[3]};
            const int cr = rt * 64 + r; const int b = cr >> 8, tall = cr & 255; const int row = b * TPB + tall; const int c0 = ct * 64 + cg * 8;
            const ColVec cv = load_colvec(E, E.wsp, E.l, 4, c0);
            const float rstd = (E.mode <= 2) ? row_rstd(E, E.wsp, E.l, row) : 0.f;
            float ss = emit8(E, E.wsp, E.l, row, b, tall, true, c0, v, cv, rstd);
            if (E.mode == 3) { ss += __shfl_xor(ss, 1); ss += __shfl_xor(ss, 2); ss += __shfl_xor(ss, 4);
                if (cg == 0) rowsq_out_ptr(E, E.wsp, E.l)[(size_t)row * 16 + ct] = ss; }
        }
        __syncthreads();
    }
#undef MINI_LOAD
}

DI bf16x8 pack8(const f32x16& x, int s) {
    u32x4 p; p.x = pk2(x[8 * s], x[8 * s + 1]); p.y = pk2(x[8 * s + 2], x[8 * s + 3]); p.z = pk2(x[8 * s + 4], x[8 * s + 5]); p.w = pk2(x[8 * s + 6], x[8 * s + 7]);
    return __builtin_bit_cast(bf16x8, p);
}
DI bool softmax_tile(f32x16& s0, f32x16& s1, f32x16& negm, float& mref, float& l, const bool first, float& alpha) {
    float mx = fmaxf(s0[0], s1[0]);
#pragma unroll
    for (int i = 1; i < 16; ++i) mx = fmaxf(fmaxf(mx, s0[i]), s1[i]);
    mx = fmaxf(mx, __shfl_xor(mx, 32));
    const bool resc = first || (__builtin_amdgcn_ballot_w64(mx > 8.0f) != 0ull);
    alpha = 1.0f;
    if (resc) {
        const float delta = first ? mx : fmaxf(mx, 0.f);
        mref += delta;
        const float nm = -mref;
#pragma unroll
        for (int i = 0; i < 16; ++i) { negm[i] = nm; s0[i] -= delta; s1[i] -= delta; }
        alpha = __builtin_amdgcn_exp2f(-delta);
        l *= alpha;
    }
    float sum = 0.f;
#pragma unroll
    for (int i = 0; i < 16; ++i) { s0[i] = __builtin_amdgcn_exp2f(s0[i]); sum += s0[i]; }
#pragma unroll
    for (int i = 0; i < 16; ++i) { s1[i] = __builtin_amdgcn_exp2f(s1[i]); sum += s1[i]; }
    l += sum;
    return resc;
}

template <bool ALLOW_NA> DI void na_item(const P& p, unsigned char* shm, int wv, int j, unsigned item, int lane) {
    const bf16_t* QK = (const bf16_t*)(p.ws + OFF_QK);
    const bf16_t* VT = (const bf16_t*)(p.ws + OFF_VT);
    bf16_t* CAT = (bf16_t*)(p.ws + OFF_CAT);
    const int l31 = lane & 31, hi = lane >> 5;
    int b, h, qrow, ntiles, r = 0, qc = 0; bool na;
    if (ALLOW_NA && item < 4096u) { na = true; const int half = item & 1; h = (item >> 1) & 7; r = (item >> 4) & 63; b = item >> 10; qc = half * 32 + l31; qrow = b * TPB + 256 + r * 64 + qc; ntiles = 12; }
    else { const int it = item - 4096; na = false; const int qb = it & 7; h = (it >> 3) & 7; b = it >> 6; qrow = b * TPB + qb * 32 + l31; ntiles = 4; }
    bf16x8 qf[4];
#pragma unroll
    for (int c = 0; c < 4; ++c) qf[c] = *(const bf16x8*)(QK + (size_t)qrow * 1024 + h * 64 + 16 * c + 8 * hi);
    const int rs = min(max(r - 4, 0), 56), cs = min(max(qc - 8, 0), 48);
    const bf16_t* vbase = VT + (size_t)((b * 8 + h) * 64) * TPB;
    const float* rpb = p.in[12] + (size_t)(j * 8 + h) * 15 * 31;
    float* tab = (float*)(shm + (size_t)wv * 8192);
    if (na) {
        for (int idx = lane; idx < 465; idx += 64) tab[(idx / 31) * 128 + 48 + idx % 31] = rpb[idx] * LOG2E;
        __builtin_amdgcn_wave_barrier();
    }
    f32x16 o[2]; float m = 0.f, l = 0.f;
#pragma unroll
    for (int d = 0; d < 2; ++d)
#pragma unroll
        for (int i = 0; i < 16; ++i) o[d][i] = 0.f;
#define NA_POS0(tt_) ((na && (tt_) < 8) ? 256 + (rs + (tt_)) * 64 : (na ? ((tt_) - 8) * 64 : (tt_) * 64))
#define NA_LOADK(KF, tt_) do { const int p0_ = NA_POS0(tt_); const bf16_t* kp_ = QK + (size_t)(b * TPB + p0_ + l31) * 1024 + 512 + h * 64 + 8 * hi; \
        _Pragma("unroll") for (int kb = 0; kb < 2; ++kb) _Pragma("unroll") for (int c = 0; c < 4; ++c) KF[kb][c] = *(const bf16x8*)(kp_ + (size_t)kb * 32 * 1024 + 16 * c); } while (0)
#define NA_LOADV(VF, tt_) do { const int p0_ = NA_POS0(tt_); const bf16_t* vp_ = vbase + (size_t)l31 * TPB + p0_ + 8 * hi; \
        _Pragma("unroll") for (int d = 0; d < 2; ++d) _Pragma("unroll") for (int q4 = 0; q4 < 4; ++q4) VF[d][q4] = *(const bf16x8*)(vp_ + (size_t)32 * d * TPB + 16 * q4); } while (0)
#define NA_LOADV1(VF, d_, tt_) do { const int p0_ = NA_POS0(tt_); const bf16_t* vp_ = vbase + (size_t)l31 * TPB + p0_ + 8 * hi; \
        _Pragma("unroll") for (int q4 = 0; q4 < 4; ++q4) VF[q4] = *(const bf16x8*)(vp_ + (size_t)32 * (d_) * TPB + 16 * q4); } while (0)
    bf16x8 kf[2][4], vf[2][4], nkf[2][4], nvf0[4];
    NA_LOADK(kf, 0); NA_LOADV1(vf[0], 0, 0);
    for (int tt = 0; tt < ntiles; ++tt) {
        const bool masked = na && tt < 8;
        NA_LOADV1(vf[1], 1, tt);
        if (tt + 1 < ntiles) { NA_LOADK(nkf, tt + 1); NA_LOADV1(nvf0, 0, tt + 1); }
        f32x16 s[2];
        { const float nm = -m;
#pragma unroll
          for (int i = 0; i < 16; ++i) { s[0][i] = nm; s[1][i] = nm; } }
#pragma unroll
        for (int kb = 0; kb < 2; ++kb) {
#pragma unroll
            for (int c = 0; c < 4; ++c) s[kb] = MFMA32(kf[kb][c], qf[c], s[kb]);
        }
        if (masked) {
            const float* trow = tab + (rs + tt - r + 7) * 128 + 63 - qc + 4 * hi;
#pragma unroll
            for (int kb = 0; kb < 2; ++kb)
#pragma unroll
                for (int i = 0; i < 16; ++i) {
                    const int kc = 32 * kb + (i & 3) + 8 * (i >> 2) + 4 * hi;
                    const bool valid = (kc >= cs) && (kc < cs + 16);
                    s[kb][i] = valid ? s[kb][i] + trow[32 * kb + (i & 3) + 8 * (i >> 2)] : -1e30f;
                }
        }
        {
            float mx = fmaxf(s[0][0], s[1][0]);
#pragma unroll
            for (int i = 1; i < 16; ++i) mx = fmaxf(fmaxf(mx, s[0][i]), s[1][i]);
            mx = fmaxf(mx, __shfl_xor(mx, 32));
            if (tt == 0 || (__builtin_amdgcn_ballot_w64(mx > 8.0f) != 0ull)) {
                const float delta = (tt == 0) ? mx : fmaxf(mx, 0.f);
                m += delta;
#pragma unroll
                for (int i = 0; i < 16; ++i) { s[0][i] -= delta; s[1][i] -= delta; }
                const float alpha = __builtin_amdgcn_exp2f(-delta);
                l *= alpha;
#pragma unroll
                for (int d = 0; d < 2; ++d)
#pragma unroll
                    for (int i = 0; i < 16; ++i) o[d][i] *= alpha;
            }
            float sum = 0.f;
#pragma unroll
            for (int i = 0; i < 16; ++i) { s[0][i] = __builtin_amdgcn_exp2f(s[0][i]); sum += s[0][i]; }
#pragma unroll
            for (int i = 0; i < 16; ++i) { s[1][i] = __builtin_amdgcn_exp2f(s[1][i]); sum += s[1][i]; }
            l += sum;
        }
#pragma unroll
        for (int kb = 0; kb < 2; ++kb)
#pragma unroll
            for (int s2 = 0; s2 < 2; ++s2) {
                const bf16x8 pf = pack8(s[kb], s2);
#pragma unroll
                for (int d = 0; d < 2; ++d) o[d] = MFMA32(vf[d][2 * kb + s2], pf, o[d]);
            }
        if (tt + 1 < ntiles) {
#pragma unroll
            for (int kb = 0; kb < 2; ++kb)
#pragma unroll
                for (int c = 0; c < 4; ++c) { kf[kb][c] = nkf[kb][c]; if (kb == 0) vf[0][c] = nvf0[c]; }
        }
    }
#undef NA_LOADK
#undef NA_LOADV
#undef NA_LOADV1
#undef NA_POS0
    const float inv = 1.0f / (l + __shfl_xor(l, 32));
    bf16_t* op = CAT + (size_t)qrow * 1024 + 512 + h * 64;
#pragma unroll
    for (int d = 0; d < 2; ++d)
#pragma unroll
        for (int g = 0; g < 4; ++g) { u32x2 w; w.x = pk2(o[d][4 * g] * inv, o[d][4 * g + 1] * inv); w.y = pk2(o[d][4 * g + 2] * inv, o[d][4 * g + 3] * inv);
            *(u32x2*)(op + 32 * d + 8 * g + 4 * hi) = w; }
}

DI void na_half(const unsigned char* Kh, const unsigned char* Vh, const int sw, const int hi, const bf16x8 (&qf)[4], f32x16& o0, f32x16& o1, float& m, float& lsum,
                const bool masked, const bool first, const float rowval, const int qc) {
    f32x16 s0, s1;
    { const float nm = -m;
#pragma unroll
      for (int i = 0; i < 16; ++i) { s0[i] = nm; s1[i] = nm; } }
#pragma unroll
    for (int c = 0; c < 4; ++c) { const bf16x8 kf = *(const bf16x8*)(Kh + (((2 * c + hi) ^ sw) << 4)); s0 = MFMA32(kf, qf[c], s0); }
#pragma unroll
    for (int c = 0; c < 4; ++c) { const bf16x8 kf = *(const bf16x8*)(Kh + 4096 + (((2 * c + hi) ^ sw) << 4)); s1 = MFMA32(kf, qf[c], s1); }
    if (masked) {
        const int cs = min(max(qc - 8, 0), 48);
        int ib = (4 * hi - qc + 15) * 4; asm volatile("" : "+v"(ib));
        int rel = cs - 4 * hi; asm volatile("" : "+v"(rel));
#pragma unroll
        for (int i = 0; i < 16; ++i) {
            const int kcc = (i & 3) + 8 * (i >> 2);
            const float b0 = __int_as_float(__builtin_amdgcn_ds_bpermute(ib + 4 * kcc, __float_as_int(rowval)));
            const float b1 = __int_as_float(__builtin_amdgcn_ds_bpermute(ib + 4 * (kcc + 32), __float_as_int(rowval)));
            s0[i] = ((unsigned)(kcc - rel) < 16u) ? s0[i] + b0 : -1e30f;
            s1[i] = ((unsigned)(kcc + 32 - rel) < 16u) ? s1[i] + b1 : -1e30f;
        }
    }
    float mx = fmaxf(s0[0], s1[0]);
#pragma unroll
    for (int i = 1; i < 16; ++i) mx = fmaxf(fmaxf(mx, s0[i]), s1[i]);
    mx = fmaxf(mx, __shfl_xor(mx, 32));
    if (first || (__builtin_amdgcn_ballot_w64(mx > 8.0f) != 0ull)) {
        const float delta = first ? mx : fmaxf(mx, 0.f);
        m += delta;
#pragma unroll
        for (int i = 0; i < 16; ++i) { s0[i] -= delta; s1[i] -= delta; }
        const float alpha = __builtin_amdgcn_exp2f(-delta);
        lsum *= alpha;
#pragma unroll
        for (int i = 0; i < 16; ++i) { o0[i] *= alpha; o1[i] *= alpha; }
    }
    float sum = 0.f;
#pragma unroll
    for (int i = 0; i < 16; ++i) { s0[i] = __builtin_amdgcn_exp2f(s0[i]); sum += s0[i]; }
#pragma unroll
    for (int i = 0; i < 16; ++i) { s1[i] = __builtin_amdgcn_exp2f(s1[i]); sum += s1[i]; }
    lsum += sum;
#pragma unroll
    for (int s2 = 0; s2 < 2; ++s2) {
        const bf16x8 pf = pack8(s0, s2);
        const bf16x8 v0 = *(const bf16x8*)(Vh + (((2 * s2 + hi) ^ sw) << 4)), v1 = *(const bf16x8*)(Vh + 4096 + (((2 * s2 + hi) ^ sw) << 4));
        o0 = MFMA32(v0, pf, o0); o1 = MFMA32(v1, pf, o1);
    }
#pragma unroll
    for (int s2 = 0; s2 < 2; ++s2) {
        const bf16x8 pf = pack8(s1, s2);
        const bf16x8 v0 = *(const bf16x8*)(Vh + (((4 + 2 * s2 + hi) ^ sw) << 4)), v1 = *(const bf16x8*)(Vh + 4096 + (((4 + 2 * s2 + hi) ^ sw) << 4));
        o0 = MFMA32(v0, pf, o0); o1 = MFMA32(v1, pf, o1);
    }
}
DI void na_store(bf16_t* op, const f32x16& o0, const f32x16& o1, const float lsum, const int hi) {
    const float inv = 1.0f / (lsum + __shfl_xor(lsum, 32));
#pragma unroll
    for (int g = 0; g < 4; ++g) {
        u32x2 w; w.x = pk2(o0[4 * g] * inv, o0[4 * g + 1] * inv); w.y = pk2(o0[4 * g + 2] * inv, o0[4 * g + 3] * inv); *(u32x2*)(op + 8 * g + 4 * hi) = w;
        w.x = pk2(o1[4 * g] * inv, o1[4 * g + 1] * inv); w.y = pk2(o1[4 * g + 2] * inv, o1[4 * g + 3] * inv); *(u32x2*)(op + 32 + 8 * g + 4 * hi) = w; }
}
DI void na_block_item(const P& p, unsigned char* shm, int j, int item, int tid) {
    const bf16_t* QK = (const bf16_t*)(p.ws + OFF_QK);
    const bf16_t* VT = (const bf16_t*)(p.ws + OFF_VT);
    bf16_t* CAT = (bf16_t*)(p.ws + OFF_CAT);
    const int h = tid >> 6, lane = tid & 63, l31 = lane & 31, hi = lane >> 5;
    const int b = item >> 6, r = item & 63;
    const int rs = min(max(r - 4, 0), 56);
    const float* rpb = p.in[12] + (size_t)(j * 8 + h) * 15 * 31;
    bf16x8 qa[4], qb[4];
#pragma unroll
    for (int c = 0; c < 4; ++c) { qa[c] = *(const bf16x8*)(QK + (size_t)(b * TPB + 256 + r * 64 + l31) * 1024 + h * 64 + 16 * c + 8 * hi);
                                  qb[c] = *(const bf16x8*)(QK + (size_t)(b * TPB + 256 + r * 64 + 32 + l31) * 1024 + h * 64 + 16 * c + 8 * hi); }
    f32x16 oa0, oa1, ob0, ob1; float ma = 0.f, mb = 0.f, la = 0.f, lb = 0.f;
#pragma unroll
    for (int i = 0; i < 16; ++i) { oa0[i] = 0.f; oa1[i] = 0.f; ob0[i] = 0.f; ob1[i] = 0.f; }
    const int sw = (l31 >> 1) & 7;
    const unsigned char* Kh = shm + h * 8192 + l31 * 128;
    const unsigned char* Vh = shm + 65536 + h * 8192 + l31 * 128;
    for (int tt = 0; tt < 12; ++tt) {
        const bool masked = tt < 8;
        const int pos0 = masked ? 256 + (rs + tt) * 64 : (tt - 8) * 64;
        __syncthreads();
        {
            int tl = tid; asm volatile("" : "+v"(tl));
            const int krow = tl >> 6, kcb = tl & 63;
            const int kdst = (kcb >> 3) * 8192 + krow * 128;
            const int vrow = tl >> 3, vch = tl & 7;
            const int vdst = 65536 + vrow * 128 + ((vch ^ ((vrow >> 1) & 7)) << 4);
            const bf16_t* ks = QK + (size_t)(b * TPB + pos0 + krow) * 1024 + 512 + kcb * 8;
            const bf16_t* vs = VT + (size_t)((b * 8) * 64 + vrow) * TPB + pos0 + vch * 8;
            u32x4 tk[8], tv[8];
#pragma unroll
            for (int i = 0; i < 8; ++i) tk[i] = *(const u32x4*)(ks + (size_t)i * 8 * 1024);
#pragma unroll
            for (int i = 0; i < 8; ++i) tv[i] = *(const u32x4*)(vs + (size_t)i * 64 * TPB);
#pragma unroll
            for (int i = 0; i < 8; ++i) { const int row = krow + 8 * i; *(u32x4*)(shm + kdst + i * 1024 + (((kcb & 7) ^ ((row >> 1) & 7)) << 4)) = tk[i]; }
#pragma unroll
            for (int i = 0; i < 8; ++i) *(u32x4*)(shm + vdst + i * 8192) = tv[i];
        }
        __syncthreads();
        float rowval = 0.f;
        if (masked) rowval = rpb[(rs + tt - r + 7) * 31 + min(lane, 30)] * LOG2E;
        __builtin_amdgcn_sched_barrier(0);
        na_half(Kh, Vh, sw, hi, qa, oa0, oa1, ma, la, masked, tt == 0, rowval, l31);
        __builtin_amdgcn_sched_barrier(0);
        na_half(Kh, Vh, sw, hi, qb, ob0, ob1, mb, lb, masked, tt == 0, rowval, 32 + l31);
        __builtin_amdgcn_sched_barrier(0);
    }
    {
        int t2 = tid; asm volatile("" : "+v"(t2));
        const int h2 = t2 >> 6, l2 = t2 & 31, hi2 = (t2 >> 5) & 1;
        bf16_t* op = CAT + (size_t)(b * TPB + 256 + r * 64 + l2) * 1024 + 512 + h2 * 64;
        na_store(op, oa0, oa1, la, hi2);
        na_store(op + (size_t)32 * 1024, ob0, ob1, lb, hi2);
    }
    __syncthreads();
}

constexpr int DA_ROW = 144, DA_KBYTES = 2 * 64 * DA_ROW, DA_STAGE = DA_KBYTES + 128 * DA_ROW;
DI void diff_item(const P& p, unsigned char* shm, int l, int bh, int qrow0, int nkt, float lam, float lam_init, int tid) {
    const bf16_t* QK = (const bf16_t*)(p.ws + OFF_QK);
    const bf16_t* VT = (const bf16_t*)(p.ws + OFF_VT);
    bf16_t* CAT = (bf16_t*)(p.ws + OFF_CAT);
    const int j = l >> 1;
    const int wv = tid >> 6, lane = tid & 63, l31 = lane & 31, hi = lane >> 5, sub = wv >> 2, qw = wv & 3;
    const int b = bh >> 3, h = bh & 7;
    const int qrow = qrow0 + 32 * qw + l31;
    bf16x8 qf[4];
#pragma unroll
    for (int c = 0; c < 4; ++c) qf[c] = *(const bf16x8*)(QK + (size_t)qrow * 2048 + h * 128 + sub * 64 + 16 * c + 8 * hi);
    const bf16_t* ksrc[2]; const bf16_t* vsrc[2]; int kdst[2], vdst[2];
#pragma unroll
    for (int i = 0; i < 2; ++i) { const int id = tid + 512 * i; const int row = id >> 4, cb = id & 15;
        ksrc[i] = QK + (size_t)(b * TPB + row) * 2048 + 1024 + h * 128 + cb * 8; kdst[i] = ((cb >> 3) * 64 + row) * DA_ROW + (cb & 7) * 16;
        const int d = id >> 3, pc = id & 7;
        vsrc[i] = VT + (size_t)(bh * 128 + d) * TPB + pc * 8; vdst[i] = DA_KBYTES + d * DA_ROW + pc * 16; }
    u32x4 pre[4];
    {
        u32x4 pre1[4];
#pragma unroll
        for (int i = 0; i < 2; ++i) { pre[i] = *(const u32x4*)(ksrc[i]); pre[2 + i] = *(const u32x4*)(vsrc[i]); pre1[i] = *(const u32x4*)(ksrc[i] + (size_t)64 * 2048); pre1[2 + i] = *(const u32x4*)(vsrc[i] + 64); }
#pragma unroll
        for (int i = 0; i < 2; ++i) { *(u32x4*)(shm + kdst[i]) = pre[i]; *(u32x4*)(shm + vdst[i]) = pre[2 + i]; *(u32x4*)(shm + DA_STAGE + kdst[i]) = pre1[i]; *(u32x4*)(shm + DA_STAGE + vdst[i]) = pre1[2 + i]; }
    }
    __syncthreads();
    f32x16 o[4]; float m = 0.f, lsum = 0.f;
#pragma unroll
    for (int d = 0; d < 4; ++d)
#pragma unroll
        for (int i = 0; i < 16; ++i) o[d][i] = 0.f;
    const int koff = sub * 64 * DA_ROW + l31 * DA_ROW + 16 * hi;
    const int voff = DA_KBYTES + l31 * DA_ROW + 16 * hi;
    f32x16 s[2], sn[2];
#pragma unroll
    for (int kb = 0; kb < 2; ++kb)
#pragma unroll
        for (int c = 0; c < 4; ++c) { const bf16x8 kf = *(const bf16x8*)(shm + koff + 32 * kb * DA_ROW + 32 * c); if (c == 0) { _Pragma("unroll") for (int i = 0; i < 16; ++i) s[kb][i] = 0.f; } s[kb] = MFMA32(kf, qf[c], s[kb]); }
    float mx = fmaxf(s[0][0], s[1][0]);
#pragma unroll
    for (int i = 1; i < 16; ++i) mx = fmaxf(fmaxf(mx, s[0][i]), s[1][i]);
    mx = fmaxf(mx, __shfl_xor(mx, 32));
    int st_cur = 0, st_nxt = DA_STAGE, st_ld = 2 * DA_STAGE;
    for (int kt = 0; kt < nkt; ++kt) {
        const bool more = (kt + 2 < nkt);
        if (more) {
#pragma unroll
            for (int i = 0; i < 2; ++i) { pre[i] = *(const u32x4*)(ksrc[i] + (size_t)(kt + 2) * 64 * 2048); pre[2 + i] = *(const u32x4*)(vsrc[i] + (kt + 2) * 64); }
        }
        if (kt == 0 || (__builtin_amdgcn_ballot_w64(mx > 8.0f) != 0ull)) {
            const float delta = (kt == 0) ? mx : fmaxf(mx, 0.f);
            m += delta;
#pragma unroll
            for (int i = 0; i < 16; ++i) { s[0][i] -= delta; s[1][i] -= delta; }
            const float alpha = __builtin_amdgcn_exp2f(-delta);
            lsum *= alpha;
#pragma unroll
            for (int d = 0; d < 4; ++d)
#pragma unroll
                for (int i = 0; i < 16; ++i) o[d][i] *= alpha;
        }
        if (sub == 0) __builtin_amdgcn_s_setprio(1);
        const unsigned char* Kn = shm + st_nxt + koff;
        const unsigned char* Vc = shm + st_cur + voff;
        bf16x8 kf[8];
#pragma unroll
        for (int kb = 0; kb < 2; ++kb)
#pragma unroll
            for (int c = 0; c < 4; ++c) kf[kb * 4 + c] = *(const bf16x8*)(Kn + 32 * kb * DA_ROW + 32 * c);
        { const float nm = -m;
#pragma unroll
          for (int i = 0; i < 16; ++i) { sn[0][i] = nm; sn[1][i] = nm; } }
        __builtin_amdgcn_sched_barrier(0);
#pragma unroll
        for (int kb = 0; kb < 2; ++kb)
#pragma unroll
            for (int c = 0; c < 4; ++c) sn[kb] = MFMA32(kf[kb * 4 + c], qf[c], sn[kb]);
        float sum = 0.f;
#pragma unroll
        for (int i = 0; i < 16; ++i) { s[0][i] = __builtin_amdgcn_exp2f(s[0][i]); sum += s[0][i]; }
        const bf16x8 p00 = pack8(s[0], 0), p01 = pack8(s[0], 1);
        __builtin_amdgcn_sched_barrier(0);
        bf16x8 vf[8];
#pragma unroll
        for (int d = 0; d < 4; ++d) { vf[2 * d] = *(const bf16x8*)(Vc + 32 * d * DA_ROW); vf[2 * d + 1] = *(const bf16x8*)(Vc + 32 * d * DA_ROW + 32); }
        __builtin_amdgcn_sched_barrier(0);
#pragma unroll
        for (int d = 0; d < 4; ++d) { o[d] = MFMA32(vf[2 * d], p00, o[d]); o[d] = MFMA32(vf[2 * d + 1], p01, o[d]); }
#pragma unroll
        for (int i = 0; i < 16; ++i) { s[1][i] = __builtin_amdgcn_exp2f(s[1][i]); sum += s[1][i]; }
        lsum += sum;
        const bf16x8 p10 = pack8(s[1], 0), p11 = pack8(s[1], 1);
        __builtin_amdgcn_sched_barrier(0);
#pragma unroll
        for (int d = 0; d < 4; ++d) { vf[2 * d] = *(const bf16x8*)(Vc + 32 * d * DA_ROW + 64); vf[2 * d + 1] = *(const bf16x8*)(Vc + 32 * d * DA_ROW + 96); }
        __builtin_amdgcn_sched_barrier(0);
#pragma unroll
        for (int d = 0; d < 4; ++d) { o[d] = MFMA32(vf[2 * d], p10, o[d]); o[d] = MFMA32(vf[2 * d + 1], p11, o[d]); }
        __builtin_amdgcn_s_setprio(0);
        mx = fmaxf(sn[0][0], sn[1][0]);
#pragma unroll
        for (int i = 1; i < 16; ++i) mx = fmaxf(fmaxf(mx, sn[0][i]), sn[1][i]);
        mx = fmaxf(mx, __shfl_xor(mx, 32));
        if (more) {
#pragma unroll
            for (int i = 0; i < 2; ++i) { *(u32x4*)(shm + st_ld + kdst[i]) = pre[i]; *(u32x4*)(shm + st_ld + vdst[i]) = pre[2 + i]; }
        }
        __syncthreads();
        s[0] = sn[0]; s[1] = sn[1];
        const int t_ = st_cur; st_cur = st_nxt; st_nxt = st_ld; st_ld = t_;
    }
    const float inv = 1.0f / (lsum + __shfl_xor(lsum, 32));
    f32x4* xch = (f32x4*)shm;
    if (sub == 1) {
#pragma unroll
        for (int d = 0; d < 4; ++d)
#pragma unroll
            for (int g = 0; g < 4; ++g) xch[(qw * 16 + d * 4 + g) * 64 + lane] = (f32x4){o[d][4 * g] * inv, o[d][4 * g + 1] * inv, o[d][4 * g + 2] * inv, o[d][4 * g + 3] * inv};
    }
    __syncthreads();
    if (sub == 0) {
        int lq = l; asm volatile("" : "+s"(lq));
        const float lam2 = ((const float*)(p.ws + OFF_LAM))[lq >> 1];
        const float lam_init2 = 0.8f - 0.6f * expf(-0.3f * (float)lq);
        float ss = 0.f;
#pragma unroll
        for (int d = 0; d < 4; ++d)
#pragma unroll
            for (int g = 0; g < 4; ++g) { const f32x4 o2 = xch[(qw * 16 + d * 4 + g) * 64 + lane];
#pragma unroll
                for (int i = 0; i < 4; ++i) { const float y = o[d][4 * g + i] * inv - lam2 * o2[i]; o[d][4 * g + i] = y; ss += y * y; } }
        ss += __shfl_xor(ss, 32);
        const float rn = rsqrtf(ss * (1.0f / 128.0f) + 1e-5f) * (1.0f - lam_init2);
        const float* sg = p.in[19] + j * 128;
        bf16_t* op = CAT + (size_t)qrow * 1024 + h * 128;
#pragma unroll
        for (int d = 0; d < 4; ++d)
#pragma unroll
            for (int g = 0; g < 4; ++g) { const int d0 = 32 * d + 8 * g + 4 * hi; const f32x4 gg = *(const f32x4*)(sg + d0);
                u32x2 w; w.x = pk2(o[d][4 * g] * rn * gg[0], o[d][4 * g + 1] * rn * gg[1]); w.y = pk2(o[d][4 * g + 2] * rn * gg[2], o[d][4 * g + 3] * rn * gg[3]);
                *(u32x2*)(op + d0) = w; }
    }
    __syncthreads();
}

DI void transpose_item(const float* W, int ldw, bf16_t* WT, int K, int item, int nblk, float* scr, int lane) {
    const int kb = item / nblk, nb = item % nblk, k0 = 64 * kb, n0 = 32 * nb;
#pragma unroll 8
    for (int i = 0; i < 32; ++i) { const int kk = 2 * i + (lane >> 5); scr[kk * 33 + (lane & 31)] = __builtin_nontemporal_load(W + (size_t)(k0 + kk) * ldw + n0 + (lane & 31)); }
    __builtin_amdgcn_wave_barrier();
    const int c = lane & 7;
#pragma unroll
    for (int jx = 0; jx < 4; ++jx) { const int n = (lane >> 3) + 8 * jx; const float* s = scr + (8 * c) * 33 + n;
        u32x4 o; o.x = pk2(s[0 * 33], s[1 * 33]); o.y = pk2(s[2 * 33], s[3 * 33]); o.z = pk2(s[4 * 33], s[5 * 33]); o.w = pk2(s[6 * 33], s[7 * 33]);
        *(u32x4*)(WT + (size_t)(n0 + n) * K + k0 + 8 * c) = o; }
    __builtin_amdgcn_wave_barrier();
}

DI void phase0(const P& p, unsigned char* shm, int tid) {
    float* ldsf = (float*)shm;
    const int wv = tid >> 6, lane = tid & 63;
    const int G = gridDim.x, blk = blockIdx.x;
    float* MOD = (float*)(p.ws + OFF_MOD);
    {
        for (int i = tid; i < 5120; i += 512) { const int r = i >> 10, k = i & 1023; const float v = r < 4 ? p.in[1][r * 1024 + k] : p.in[3][k]; ldsf[i] = v / (1.0f + expf(-v)); }
        __syncthreads();
        float* red = ldsf + 5120;
        const int col32 = lane & 31, ksub = lane >> 5;
        for (int item = blk; item < 768; item += G) {
            const int l = item / 192, n0 = (item % 192) * 32;
            const float* W = p.in[4] + (size_t)l * 1024 * 6144 + n0 + col32;
            float a0 = 0.f, a1 = 0.f, a2 = 0.f, a3 = 0.f, a4 = 0.f;
#pragma unroll 8
            for (int i = 0; i < 64; ++i) { const int k = wv * 128 + 2 * i + ksub; const float w = __builtin_nontemporal_load(W + (size_t)k * 6144);
                a0 += ldsf[k] * w; a1 += ldsf[1024 + k] * w; a2 += ldsf[2048 + k] * w; a3 += ldsf[3072 + k] * w; a4 += ldsf[4096 + k] * w; }
            a0 += __shfl_xor(a0, 32); a1 += __shfl_xor(a1, 32); a2 += __shfl_xor(a2, 32); a3 += __shfl_xor(a3, 32); a4 += __shfl_xor(a4, 32);
            if (lane < 32) { red[(wv * 5 + 0) * 32 + lane] = a0; red[(wv * 5 + 1) * 32 + lane] = a1; red[(wv * 5 + 2) * 32 + lane] = a2; red[(wv * 5 + 3) * 32 + lane] = a3; red[(wv * 5 + 4) * 32 + lane] = a4; }
            __syncthreads();
            if (tid < 160) { const int r = tid >> 5, cl = tid & 31; float s = 0.f;
#pragma unroll
                for (int w = 0; w < 8; ++w) s += red[(w * 5 + r) * 32 + cl];
                MOD[(size_t)(l * 5 + r) * 6144 + n0 + cl] = s + p.in[5][l * 6144 + n0 + cl]; }
            __syncthreads();
        }
    }
    {
        float* tile = ldsf; float* tabc = ldsf + 8192; float* tabs = ldsf + 8320;
        if (tid < 128) { tabc[tid] = cospif((float)tid * (1.0f / 64.0f)); tabs[tid] = sinpif((float)tid * (1.0f / 64.0f)); }
        for (int item = blk; item < 128; item += G) {
            const int jj = item >> 6, g = (item >> 4) & 3, k0 = (item & 15) * 64;
            __syncthreads();
#pragma unroll
            for (int i = 0; i < 16; ++i) { const int idx = tid + 512 * i; const int row = idx >> 7, col = idx & 127; tile[idx] = p.in[10][(size_t)jj * 1024 * 2048 + (size_t)(k0 + row) * 2048 + g * 128 + col]; }
            __syncthreads();
            const int c = tid >> 2, kq = tid & 3;
            float ac[16], as[16];
#pragma unroll
            for (int i = 0; i < 16; ++i) { ac[i] = 0.f; as[i] = 0.f; }
            for (int cp = 0; cp < 128; ++cp) { const int idx = (c * cp) & 127; const float tc = tabc[idx], ts = tabs[idx];
#pragma unroll
                for (int kk = 0; kk < 16; ++kk) { const float x = tile[(kq * 16 + kk) * 128 + cp]; ac[kk] += x * tc; as[kk] += x * ts; } }
            bf16_t* WT = (bf16_t*)(p.ws + OFF_WINAB) + (size_t)jj * 2560 * 1024;
            u32x4 w0, w1;
            w0.x = pk2(ac[0], ac[1]); w0.y = pk2(ac[2], ac[3]); w0.z = pk2(ac[4], ac[5]); w0.w = pk2(ac[6], ac[7]);
            w1.x = pk2(ac[8], ac[9]); w1.y = pk2(ac[10], ac[11]); w1.z = pk2(ac[12], ac[13]); w1.w = pk2(ac[14], ac[15]);
            u32x4* d0 = (u32x4*)(WT + (size_t)(g * 128 + c) * 1024 + k0 + kq * 16); d0[0] = w0; d0[1] = w1;
            w0.x = pk2(as[0], as[1]); w0.y = pk2(as[2], as[3]); w0.z = pk2(as[4], as[5]); w0.w = pk2(as[6], as[7]);
            w1.x = pk2(as[8], as[9]); w1.y = pk2(as[10], as[11]); w1.z = pk2(as[12], as[13]); w1.w = pk2(as[14], as[15]);
            u32x4* d1 = (u32x4*)(WT + (size_t)(512 + g * 128 + c) * 1024 + k0 + kq * 16); d1[0] = w0; d1[1] = w1;
        }
    }
    __syncthreads();
    {
        float* scr = ldsf + 8192 + wv * 2112;
        unsigned* t1ctr = (unsigned*)(p.ws + OFF_CTL) + 16;
        for (;;) {
            unsigned itu = 0;
            if (lane == 0) itu = __hip_atomic_fetch_add(t1ctr, 1u, __ATOMIC_RELAXED, __HIP_MEMORY_SCOPE_AGENT);
            const int chunk = __builtin_amdgcn_readfirstlane((int)itu);
            if (chunk >= 1536) break;
            for (int it = chunk * 15; it < chunk * 15 + 15; ++it) {
            int r = it; const float* W; int ldw, K, nblk; bf16_t* WT;
            if (r < 1536) { const int jj = r / 768; r %= 768; W = p.in[10] + (size_t)jj * 1024 * 2048 + 512; ldw = 2048; WT = (bf16_t*)(p.ws + OFF_WINAB) + ((size_t)jj * 2560 + 1024) * 1024; K = 1024; nblk = 48; }
            else if ((r -= 1536) < 1024) { const int jj = r / 512; r %= 512; W = p.in[11] + (size_t)jj * 1024 * 1024; ldw = 1024; WT = (bf16_t*)(p.ws + OFF_WOUTAB) + (size_t)jj * 1024 * 1024; K = 1024; nblk = 32; }
            else if ((r -= 1024) < 3072) { const int jj = r / 1536; r %= 1536; W = p.in[13] + (size_t)jj * 1024 * 3072; ldw = 3072; WT = (bf16_t*)(p.ws + OFF_WQKV) + (size_t)jj * 3072 * 1024; K = 1024; nblk = 96; }
            else if ((r -= 3072) < 1024) { const int jj = r / 512; r %= 512; W = p.in[14] + (size_t)jj * 1024 * 1024; ldw = 1024; WT = (bf16_t*)(p.ws + OFF_WOUTD) + (size_t)jj * 1024 * 1024; K = 1024; nblk = 32; }
            else if ((r -= 1024) < 8192) { const int ll = r / 2048; r %= 2048; W = p.in[8] + (size_t)ll * 1024 * 4096; ldw = 4096; WT = (bf16_t*)(p.ws + OFF_WMI) + (size_t)ll * 4096 * 1024; K = 1024; nblk = 128; }
            else { r -= 8192; const int ll = r / 2048; r %= 2048; W = p.in[9] + (size_t)ll * 4096 * 1024; ldw = 1024; WT = (bf16_t*)(p.ws + OFF_WMO) + (size_t)ll * 1024 * 4096; K = 4096; nblk = 32; }
            transpose_item(W, ldw, WT, K, r, nblk, scr, lane);
            }
        }
    }
    __syncthreads();
    {
        float* tab = ldsf;
        for (int i = tid; i < 4096; i += 512) tab[i] = cospif((float)i * (1.0f / 2048.0f));
        __syncthreads();
        bf16_t* D1 = (bf16_t*)(p.ws + OFF_D128);
        for (int idx = blk * 512 + tid; idx < 65536; idx += G * 512) {
            const int n = idx >> 8, k = idx & 255; const int mm = ((n & 127) * (k & 127)) & 127;
            const float c = tab[(32 * mm) & 4095], sn = tab[(32 * mm - 1024) & 4095];
            const float val = (n < 128) ? (k < 128 ? c : sn) : (k < 128 ? -sn : c);
            D1[idx] = bf1(val);
        }
        bf16_t* DC = (bf16_t*)(p.ws + OFF_DFTC);
        for (int row = blk; row < 256; row += G) {
            if (tid < 32) { const int n0 = tid * 8; float c8[8], s8[8];
#pragma unroll
                for (int e = 0; e < 8; ++e) { const int idx = (16 * row * (n0 + e)) & 4095; c8[e] = tab[idx]; s8[e] = -tab[(idx - 1024) & 4095]; }
                u32x4 w; w.x = pk2(c8[0], c8[1]); w.y = pk2(c8[2], c8[3]); w.z = pk2(c8[4], c8[5]); w.w = pk2(c8[6], c8[7]);
                *(u32x4*)(DC + (size_t)row * 512 + n0) = w;
                w.x = pk2(s8[0], s8[1]); w.y = pk2(s8[2], s8[3]); w.z = pk2(s8[4], s8[5]); w.w = pk2(s8[6], s8[7]);
                *(u32x4*)(DC + (size_t)row * 512 + 256 + n0) = w; }
        }
    }
    if (blk == G - 1) {
        float* rope = (float*)(p.ws + OFF_ROPE);
        for (int i = tid; i < 1024; i += 512) { const int pos = i >> 4, jf = i & 15; const float inv = powf(10000.0f, -(float)jf / 16.0f); const float ang = (float)pos * inv; rope[2 * i] = cosf(ang); rope[2 * i + 1] = sinf(ang); }
        if (tid < 2) { float s1 = 0.f, s2 = 0.f; for (int d = 0; d < 64; ++d) { s1 += p.in[15][tid * 64 + d] * p.in[16][tid * 64 + d]; s2 += p.in[17][tid * 64 + d] * p.in[18][tid * 64 + d]; }
            const float lam_init = 0.8f - 0.6f * expf(-0.3f * (float)(2 * tid + 1));
            ((float*)(p.ws + OFF_LAM))[tid] = expf(s1) - expf(s2) + lam_init; }
    }
}

DI void phase0b(const P& p, int tid) {
    const int wv = tid >> 6, lane = tid & 63;
    const int gw = blockIdx.x * 8 + wv, NGW = gridDim.x * 8;
    const float* MOD = (const float*)(p.ws + OFF_MOD);
    {
        bf16_t* XB = (bf16_t*)(p.ws + OFF_XB); float* RSQ = (float*)(p.ws + OFF_RSQ16);
        for (int row = gw; row < NROWS; row += NGW) {
            const int b = row / TPB, tall = row % TPB; const bool isctx = tall < 256; const int bsel = isctx ? 4 : b;
            const float* src = isctx ? p.in[2] + (size_t)(b * 256 + tall) * 1024 : p.in[0] + (size_t)(b * 4096 + tall - 256) * 1024;
            const float* sc = MOD + (size_t)bsel * 6144 + 1024;
            float ss = 0.f;
#pragma unroll
            for (int jj = 0; jj < 4; ++jj) { const int n = 4 * lane + 256 * jj; const f32x4 v = __builtin_nontemporal_load((const f32x4*)(src + n));
                const f32x4 gs = *(const f32x4*)(p.in[6] + n) * (*(const f32x4*)(sc + n) + 1.0f); const f32x4 y = v * gs;
                ss += (v[0] * v[0] + v[1] * v[1]) + (v[2] * v[2] + v[3] * v[3]);
                u32x2 w; w.x = pk2(y[0], y[1]); w.y = pk2(y[2], y[3]); *(u32x2*)(XB + (size_t)row * 1024 + n) = w; }
            ss = wave_sum(ss);
            if (lane < 16) RSQ[(size_t)row * 16 + lane] = (lane == 0) ? ss : 0.f;
        }
    }
    {
        for (int it = gw; it < 28672; it += NGW) {
            const bf16_t* wt; const float* sh; float* out; int ostride;
            if (it < 12288) { const int l = it / 3072, n = it % 3072; const int jj = l >> 1; const bool odd = l & 1; if (!odd && n >= 2560) continue;
                wt = odd ? (const bf16_t*)(p.ws + OFF_WQKV) + ((size_t)jj * 3072 + n) * 1024 : (const bf16_t*)(p.ws + OFF_WINAB) + ((size_t)jj * 2560 + n) * 1024;
                sh = MOD + (size_t)l * 5 * 6144; out = (float*)(p.ws + OFF_SWMIX) + (size_t)l * 5 * 3072 + n; ostride = 3072; }
            else { const int r = it - 12288; const int l = r / 4096, n = r % 4096;
                wt = (const bf16_t*)(p.ws + OFF_WMI) + ((size_t)l * 4096 + n) * 1024;
                sh = MOD + (size_t)l * 5 * 6144 + 3072; out = (float*)(p.ws + OFF_SWMLP) + (size_t)l * 5 * 4096 + n; ostride = 4096; }
            const u32x4 wa = *(const u32x4*)(wt + lane * 16), wb = *(const u32x4*)(wt + lane * 16 + 8);
            float wf[16];
            wf[0] = __uint_as_float(wa.x << 16); wf[1] = __uint_as_float(wa.x & 0xffff0000u); wf[2] = __uint_as_float(wa.y << 16); wf[3] = __uint_as_float(wa.y & 0xffff0000u);
            wf[4] = __uint_as_float(wa.z << 16); wf[5] = __uint_as_float(wa.z & 0xffff0000u); wf[6] = __uint_as_float(wa.w << 16); wf[7] = __uint_as_float(wa.w & 0xffff0000u);
            wf[8] = __uint_as_float(wb.x << 16); wf[9] = __uint_as_float(wb.x & 0xffff0000u); wf[10] = __uint_as_float(wb.y << 16); wf[11] = __uint_as_float(wb.y & 0xffff0000u);
            wf[12] = __uint_as_float(wb.z << 16); wf[13] = __uint_as_float(wb.z & 0xffff0000u); wf[14] = __uint_as_float(wb.w << 16); wf[15] = __uint_as_float(wb.w & 0xffff0000u);
#pragma unroll
            for (int r = 0; r < 5; ++r) { const float* s = sh + (size_t)r * 6144 + lane * 16; float a = 0.f;
#pragma unroll
                for (int q = 0; q < 4; ++q) { const f32x4 sv = *(const f32x4*)(s + 4 * q); a += sv[0] * wf[4 * q] + sv[1] * wf[4 * q + 1] + sv[2] * wf[4 * q + 2] + sv[3] * wf[4 * q + 3]; }
                a = wave_sum(a);
                if (lane == 0) out[(size_t)r * ostride] = a; }
        }
    }
}

__global__ __launch_bounds__(512, 2) void mega(P p) {
    extern __shared__ __attribute__((aligned(16))) unsigned char shm[];
    cg::grid_group grid = cg::this_grid();
    const int G = gridDim.x, blk = blockIdx.x;
    uint4& xb_words = *(uint4*)(shm + 131072);
    int wave_s = __builtin_amdgcn_readfirstlane((int)(threadIdx.x >> 6));
    if (threadIdx.x == 0) xb_words = make_uint4(0u, 0u, 0u, 0u);
    __syncthreads();
    (void)xcd_barrier_post((unsigned*)(p.ws + OFF_BAR), (volatile LAS unsigned*)&xb_words);
#define GRID_BARRIER() do { XcdBarrier xb_; unsigned z_ = 0u; asm volatile("" : "+s"(z_)); unsigned char* w_ = p.ws + z_; xb_.bar = (unsigned*)(w_ + OFF_BAR); xb_.x = xb_xcc_id(); xb_.st = (volatile LAS unsigned*)&xb_words; xcd_barrier(xb_, get_tid(wave_s)); } while (0)
    { asm volatile("" : "+s"(wave_s)); const int tid = get_tid(wave_s);
#ifndef NO_P0
    phase0(p, shm, tid);
#ifdef X_PRO_TWICE
    __syncthreads(); phase0(p, shm, tid);
#endif
#endif
    }
    grid.sync();
    { asm volatile("" : "+s"(wave_s)); const int tid = get_tid(wave_s);
#ifndef NO_P0
    phase0b(p, tid);
#endif
    }
    GRID_BARRIER();
    float* MOD = (float*)(p.ws + OFF_MOD);
    for (int ph = 0; ph < 24; ++ph) {
        asm volatile("" : "+s"(wave_s)); const int tid = get_tid(wave_s);
        const int l = ph / 6, s6 = ph % 6, j = l >> 1; const bool odd = (l & 1) != 0;
        const int s = (s6 == 2) ? 9 : (s6 < 2 ? s6 : s6 - 1);
        if (s == 9 && odd) continue;
        const int nops = (s == 1) ? (odd ? 0 : 1) : 1;
        for (int oi = 0; oi < nops; ++oi) {
            pg8::Gemm g; EpiPg8 EP; Epi& E = EP.E; int rot = 0, skip = 1;
            E.mode = 0; EP.perm = 1; E.perm = 1; E.l = l; E.s = s; E.wsp = p.ws; E.outp = p.out; E.in0 = p.in[0]; E.in2 = p.in[2]; E.in6 = p.in[6]; E.in7 = p.in[7];
            if (s == 0) {
                g.A = (const bf16_t*)(p.ws + OFF_XB); g.M = 16384; g.K = 1024;
                if (odd) { g.Bt = (const bf16_t*)(p.ws + OFF_WQKV) + (size_t)j * 3072 * 1024; g.N = 3072; E.mode = 1; }
                else { g.Bt = (const bf16_t*)(p.ws + OFF_WINAB) + (size_t)j * 2560 * 1024; g.N = 2560; E.mode = 0; g.M = NROWS; skip = 0; }
            } else if (s == 1) {
                skip = 0; g.A = (const bf16_t*)(p.ws + OFF_DFTC); g.Bt = (const bf16_t*)(p.ws + OFF_FTC); g.M = 256; g.N = 2048; g.K = 512; E.mode = 5;
            } else if (s == 9) {
                skip = 0; g.A = (const bf16_t*)(p.ws + OFF_TP); g.Bt = (const bf16_t*)(p.ws + OFF_D128); g.M = 65536; g.N = 256; g.K = 256; E.mode = 4;
            } else if (s == 2) {
                g.A = (const bf16_t*)(p.ws + OFF_CAT); g.Bt = (odd ? (const bf16_t*)(p.ws + OFF_WOUTD) : (const bf16_t*)(p.ws + OFF_WOUTAB)) + (size_t)j * 1024 * 1024; g.M = 16384; g.N = 1024; g.K = 1024;
                E.mode = 3;
            } else if (s == 3) {
                g.A = (const bf16_t*)(p.ws + OFF_XB); g.Bt = (const bf16_t*)(p.ws + OFF_WMI) + (size_t)l * 4096 * 1024; g.M = 16384; g.N = 4096; g.K = 1024;
                E.mode = 2;
            } else {
                g.A = (const bf16_t*)(p.ws + OFF_U); g.Bt = (const bf16_t*)(p.ws + OFF_WMO) + (size_t)l * 1024 * 4096; g.M = 16384; g.N = 1024; g.K = 4096;
                E.mode = 3;
            }
            pg8::StaticOrder S; S.init(g.M, g.N, G, (blk + rot) % G, skip);
            const bool has_mini = (s != 1 && s != 9 && (l < 3 || s == 0)) && !(s == 0 && !odd);
            const bool mini_first = ((blk >> 3) & 1) != 0;
            for (int pass = 0; pass < 2; ++pass) {
                if (has_mini && (pass == 0) == mini_first) {
                    const int nmt = 16 * (g.N >> 6);
                    const int tid3 = get_tid(wave_s);
                    if (g.K == 1024) mini_gemm_seq1024(E, g.A, g.Bt, (blk + 128) % G + ((l == 3 && s == 0) ? 256 : 0), nmt, G, shm, tid3);
                    else for (int mt = (blk + 128) % G; mt < nmt; mt += G) mini_gemm_tile(E, g.A, g.Bt, g.K, mt, shm, tid3);
                }
                if (pass == 0) {
                    const int tidg = get_tid(wave_s);
                    pg8::gemm_phase(( LAS unsigned char*)shm, g, S, EP, tidg);
                }
            }
        }
        if (s == 1 && !odd) {
            unsigned z2 = 0u; asm volatile("" : "+s"(z2)); unsigned char* w2 = p.ws + z2;
            const int tidf = get_tid(wave_s);
            for (int it = (blk + 248) % G; it < 512; it += G) fft_stage1_item(w2, it, tidf);
        }
        if (s == 1 || s == 9) {
            if (!odd) {
                unsigned* ctr = (unsigned*)(p.ws + OFF_CTL) + l;
                if (s == 1) { const int tidb = get_tid(wave_s); for (int bi = blk; bi < 256; bi += G) na_block_item(p, shm, j, bi, tidb); }
                const int tidn = get_tid(wave_s);
                const int lane = tidn & 63;
                for (;;) {
                    unsigned it = 0;
                    if (lane == 0) it = __hip_atomic_fetch_add(ctr, 1u, __ATOMIC_RELAXED, __HIP_MEMORY_SCOPE_AGENT);
                    it = (unsigned)__builtin_amdgcn_readfirstlane((int)it) + 4096u;
                    if (it >= 4096u + 256u) break;
#ifndef NO_NA
                    na_item<false>(p, shm, tidn >> 6, j, it, lane);
#endif
                }
            } else {
                const int tidd = get_tid(wave_s);
                const float lam = ((const float*)(p.ws + OFF_LAM))[j];
                const float lam_init = 0.8f - 0.6f * expf(-0.3f * (float)l);
                const int nitems = 1024 + (l < 3 ? 64 : 0);
                for (int v = blk; v < nitems; v += G) {
                    int bh, qrow0, nkt;
                    if (v < 1024) { const int rd = v >> 8, w = v & 255; bh = rd * 8 + (w & 7); const int qb = w >> 3; qrow0 = (bh >> 3) * TPB + 256 + qb * 128; nkt = 68; }
                    else { const int c = v - 1024; bh = c >> 1; qrow0 = (bh >> 3) * TPB + (c & 1) * 128; nkt = 4; }
#ifndef NO_DIFF
                    diff_item(p, shm, l, bh, qrow0, nkt, lam, lam_init, tidd);
#ifdef X_DIFF_TWICE
                    diff_item(p, shm, l, bh, qrow0, nkt, lam, lam_init, tidd);
#endif
#endif
                }
            }
        }
        GRID_BARRIER();
#ifdef X_EXTRA_SYNC
        GRID_BARRIER();
#endif
    }
    {
        asm volatile("" : "+s"(wave_s)); const int tid = get_tid(wave_s);
        const int wv = tid >> 6, lane = tid & 63;
        const float* rs = (const float*)(p.ws + OFF_RSQ16) + (size_t)8 * NROWS * 16;
        for (int row = blk * 8 + wv; row < 16384; row += G * 8) {
            const int b = row >> 12, t = row & 4095;
            const f32x4* q4 = (const f32x4*)(rs + (size_t)(b * TPB + 256 + t) * 16);
            const f32x4 tq = (q4[0] + q4[1]) + (q4[2] + q4[3]);
            const float rstd = rsqrtf(((tq[0] + tq[1]) + (tq[2] + tq[3])) * (1.0f / 1024.0f) + 1e-6f);
            float* o = p.out + (size_t)row * 1024;
#pragma unroll
            for (int jj = 0; jj < 4; ++jj) { const int n = 4 * lane + 256 * jj; f32x4 v = *(const f32x4*)(o + n); v = v * rstd * *(const f32x4*)(p.in[20] + n); __builtin_nontemporal_store(v, (f32x4*)(o + n)); }
        }
    }
}

extern "C" void kernel_launch(void* const* d_in, const int* in_sizes, int n_in, void* d_out, int out_size, void* d_ws, size_t ws_size, hipStream_t stream) {
    static int grid_blocks = 0;
    if (grid_blocks == 0) {
        if (n_in != 21 || ws_size < WS_END) { fprintf(stderr, "kernel_launch: need 21 inputs and >= %zu bytes of workspace; got %d, %zu\n", (size_t)WS_END, n_in, ws_size); grid_blocks = -1; return; }
        int dev = 0, cus = 0, per_cu = 0;
        hipGetDevice(&dev);
        hipDeviceGetAttribute(&cus, hipDeviceAttributeMultiprocessorCount, dev);
        if (hipFuncSetAttribute((const void*)mega, hipFuncAttributeMaxDynamicSharedMemorySize, LDS_BYTES) != hipSuccess) { fprintf(stderr, "kernel_launch: hipFuncSetAttribute failed\n"); }
        if (hipOccupancyMaxActiveBlocksPerMultiprocessor(&per_cu, (const void*)mega, 512, LDS_BYTES) != hipSuccess || per_cu < 1) { fprintf(stderr, "kernel_launch: occupancy query says %d\n", per_cu); per_cu = 1; }
        (void)hipGetLastError();
        grid_blocks = cus * 1;
        fprintf(stderr, "kernel_launch: cus %d per_cu %d grid %d ws %zu need %zu\n", cus, per_cu, grid_blocks, ws_size, (size_t)WS_END);
    }
    if (grid_blocks < 0) return;
    hipMemsetAsync(d_ws, 0, CTL_BYTES, stream);
    P p{};
    for (int i = 0; i < 21; ++i) p.in[i] = (const float*)d_in[i];
    p.out = (float*)d_out; p.ws = (unsigned char*)d_ws;
    void* args[] = {&p};
    hipError_t e = hipLaunchCooperativeKernel((const void*)mega, dim3(grid_blocks), dim3(512), args, LDS_BYTES, stream);
    if (e != hipSuccess) fprintf(stderr, "cooperative launch failed: %s (grid %d)\n", hipGetErrorString(e), grid_blocks);
}
```
